# Optimizing an MI355X kernel written in HIP

```python
import jax, jax.numpy as jnp
from jax import lax
import numpy as np

D_MODEL = 1024
BATCH = 8
SEQ = 8192
DEPTH = 2

CTX_LEN = 256
GRID_W = 64
N_MIXERS = 4
GROUP_W = D_MODEL // N_MIXERS
HEADS = 4
HEAD_DIM = GROUP_W // HEADS
N_HEADS_TOTAL = N_MIXERS * HEADS
GLA_DK = HEAD_DIM // 2
GLA_RANK = 16
GLA_TAU = 16.0
D_FF = 4 * D_MODEL
CHUNK = 64
ROPE_BASE = 10000.0
RMS_EPS = 1e-6

IN_LAYOUT = (
    ('hg_q', GROUP_W), ('hg_f_fwd', GROUP_W), ('hg_f_bwd', GROUP_W), ('hg_i', GROUP_W), ('hg_g', GROUP_W),
    ('ml_q', GROUP_W), ('ml_k', GROUP_W), ('ml_v', GROUP_W), ('ml_if', 2 * 2 * HEADS), ('ml_o', GROUP_W),
    ('rt_q', GROUP_W), ('rt_k', GROUP_W), ('rt_v', GROUP_W), ('rt_g', GROUP_W),
    ('gl_q', HEADS * GLA_DK), ('gl_k', HEADS * GLA_DK), ('gl_v', GROUP_W),
    ('gl_a_fwd', GLA_RANK), ('gl_a_bwd', GLA_RANK), ('gl_g', GROUP_W),
)
IN_DIM = sum(s for _, s in IN_LAYOUT)

kernel_name = 'hybrid_bidir_recurrent_dit_block'


def rmsnorm(x):
    xf = x.astype(jnp.float32)
    return (xf * lax.rsqrt(jnp.mean(xf * xf, axis=-1, keepdims=True) + RMS_EPS)).astype(x.dtype)


def modulate(x, shift, scale):
    return rmsnorm(x) * (1.0 + scale) + shift


def split_proj(p):
    idx = np.cumsum([s for _, s in IN_LAYOUT])[:-1].tolist()
    parts = jnp.split(p, idx, axis=-1)
    return {name: t for (name, _), t in zip(IN_LAYOUT, parts)}


def to_heads(t):
    B, L, _ = t.shape
    return t.reshape(B, L, HEADS, -1).transpose(0, 2, 1, 3).astype(jnp.float32)


def from_heads(t):
    B, H, L, d = t.shape
    return t.transpose(0, 2, 1, 3).reshape(B, L, H * d)


def to_chunks(t):
    L = t.shape[2]
    t = t.reshape(t.shape[:2] + (L // CHUNK, CHUNK) + t.shape[3:])
    return jnp.moveaxis(t, 2, 0)


def from_chunks(t):
    t = jnp.moveaxis(t, 0, 2)
    return t.reshape(t.shape[:2] + (t.shape[2] * t.shape[3],) + t.shape[4:])


def chunk_linear(q, k, v, log_a, S0):
    causal = jnp.tril(jnp.ones((CHUNK, CHUNK), dtype=bool))

    def step(S, inp):
        qc, kc, vc, ac = inp
        b = jnp.cumsum(ac, axis=-2)
        if ac.shape[-1] == 1:
            diff = b[..., :, None, 0] - b[..., None, :, 0]
            decay = jnp.exp(jnp.where(causal, diff, -jnp.inf))
            attn = jnp.einsum('bhtk,bhsk->bhts', qc, kc) * decay
        else:
            diff = b[..., :, None, :] - b[..., None, :, :]
            decay = jnp.exp(jnp.where(causal[..., None], diff, -jnp.inf))
            attn = jnp.einsum('bhtk,bhsk,bhtsk->bhts', qc, kc, decay)
        b_last = b[..., -1:, :]
        o = (jnp.einsum('bhts,bhsv->bhtv', attn, vc)
             + jnp.einsum('bhtk,bhkv->bhtv', qc * jnp.exp(b), S))
        S_new = (jnp.exp(b_last[..., 0, :])[..., None] * S
                 + jnp.einsum('bhsk,bhsv->bhkv', kc * jnp.exp(b_last - b), vc))
        return S_new, o

    S, o = lax.scan(step, S0, (to_chunks(q), to_chunks(k), to_chunks(v), to_chunks(log_a)))
    return from_chunks(o), S


def chunk_mlstm(q, k, v, log_i, log_f, state):
    causal = jnp.tril(jnp.ones((CHUNK, CHUNK), dtype=bool))

    def step(carry, inp):
        Cm, n, m = carry
        qc, kc, vc, ic, fc = inp
        b = jnp.cumsum(fc, axis=-1)
        w = jnp.where(causal, b[..., :, None] - b[..., None, :] + ic[..., None, :], -jnp.inf)
        inter = b + m[..., None]
        m_t = jnp.maximum(jnp.max(w, axis=-1), inter)
        P = jnp.exp(w - m_t[..., None])
        g = jnp.exp(inter - m_t)
        s = jnp.einsum('bhtk,bhsk->bhts', qc, kc) * P
        num = (jnp.einsum('bhts,bhsv->bhtv', s, vc)
               + g[..., None] * jnp.einsum('bhtk,bhkv->bhtv', qc, Cm))
        den = jnp.sum(s, axis=-1) + g * jnp.einsum('bhtk,bhk->bht', qc, n)
        h = num / jnp.maximum(jnp.abs(den), jnp.exp(-m_t))[..., None]
        m_new = m_t[..., -1]
        a_state = jnp.exp(b[..., -1] + m - m_new)
        wk = jnp.exp(b[..., -1:] - b + ic - m_new[..., None])
        C_new = a_state[..., None, None] * Cm + jnp.einsum('bhsk,bhsv->bhkv', kc * wk[..., None], vc)
        n_new = a_state[..., None] * n + jnp.einsum('bhs,bhsk->bhk', wk, kc)
        return (C_new, n_new, m_new), h

    st, h = lax.scan(step, state, (to_chunks(q), to_chunks(k), to_chunks(v),
                                   to_chunks(log_i), to_chunks(log_f)))
    return from_chunks(h), st


def flip_seq(ts):
    return tuple(jnp.flip(t, axis=2) for t in ts)


def bidir(scan_fn, init, c_f, c_b, l_f, l_b):
    yc_f, s_f = scan_fn(*c_f, init)
    yc_b, s_b = scan_fn(*flip_seq(c_b), init)
    yl_f, _ = scan_fn(*l_f, s_f)
    yl_b, _ = scan_fn(*flip_seq(l_b), s_b)
    return yc_f + jnp.flip(yc_b, axis=2), yl_f + jnp.flip(yl_b, axis=2)


def hgrn2_inputs(p, lb_f, lb_b):
    q = jax.nn.silu(to_heads(p['hg_q']))
    v = to_heads(p['hg_i'])

    def direction(logits, lb):
        lb = lb.reshape(1, HEADS, 1, HEAD_DIM)
        z = to_heads(logits)
        log_f = jnp.logaddexp(jnp.log(lb), jnp.log1p(-lb) + jax.nn.log_sigmoid(z))
        k = (1.0 - lb) * jax.nn.sigmoid(-z)
        return (q, k, v, log_f)

    return direction(p['hg_f_fwd'], lb_f), direction(p['hg_f_bwd'], lb_b)


def hgrn2_mixer(pc, pl, lb):
    B = pl['hg_q'].shape[0]
    init = jnp.zeros((B, HEADS, HEAD_DIM, HEAD_DIM), jnp.float32)
    c_f, c_b = hgrn2_inputs(pc, lb[0], lb[1])
    l_f, l_b = hgrn2_inputs(pl, lb[0], lb[1])
    return bidir(chunk_linear, init, c_f, c_b, l_f, l_b)


def mlstm_inputs(p, gate_bias):
    q = to_heads(p['ml_q'])
    k = to_heads(p['ml_k']) * HEAD_DIM ** -0.5
    v = to_heads(p['ml_v'])
    B, L, _ = p['ml_if'].shape
    pre = p['ml_if'].astype(jnp.float32).reshape(B, L, 2, 2, HEADS) + gate_bias
    pre = jnp.transpose(pre, (2, 3, 0, 4, 1))
    fwd = (q, k, v, pre[0, 0], jax.nn.log_sigmoid(pre[0, 1]))
    bwd = (q, k, v, pre[1, 0], jax.nn.log_sigmoid(pre[1, 1]))
    return fwd, bwd


def mlstm_mixer(pc, pl, gate_bias):
    B = pl['ml_q'].shape[0]
    init = (jnp.zeros((B, HEADS, HEAD_DIM, HEAD_DIM), jnp.float32),
            jnp.zeros((B, HEADS, HEAD_DIM), jnp.float32),
            jnp.zeros((B, HEADS), jnp.float32))
    c_f, c_b = mlstm_inputs(pc, gate_bias.astype(jnp.float32))
    l_f, l_b = mlstm_inputs(pl, gate_bias.astype(jnp.float32))
    return bidir(chunk_mlstm, init, c_f, c_b, l_f, l_b)


def grid_rotary(rows):
    r = jnp.repeat(jnp.arange(rows), GRID_W).astype(jnp.float32)
    col = jnp.tile(jnp.arange(GRID_W), rows).astype(jnp.float32)
    n_freq = HEAD_DIM // 4
    inv = ROPE_BASE ** (-jnp.arange(n_freq, dtype=jnp.float32) / n_freq)
    ang_r = r[:, None] * inv[None, :]
    ang_c = col[:, None] * inv[None, :]
    return (jnp.cos(ang_r), jnp.sin(ang_r), jnp.cos(ang_c), jnp.sin(ang_c))


def rotate(x, cos, sin):
    x1, x2 = jnp.split(x, 2, axis=-1)
    return jnp.concatenate([x1 * cos - x2 * sin, x1 * sin + x2 * cos], axis=-1)


def rope2d(x, rot):
    cr, sr, cc, sc = rot
    xa, xb = jnp.split(x, 2, axis=-1)
    return jnp.concatenate([rotate(xa, cr, sr), rotate(xb, cc, sc)], axis=-1)


def retention_inputs(p, decay_logit, rot):
    q = to_heads(p['rt_q'])
    k = to_heads(p['rt_k']) * HEAD_DIM ** -0.5
    v = to_heads(p['rt_v'])
    if rot is not None:
        q = rope2d(q, rot)
        k = rope2d(k, rot)
    B, _, L, _ = q.shape
    log_g = jax.nn.log_sigmoid(decay_logit.astype(jnp.float32))
    la_f = jnp.broadcast_to(log_g[0][None, :, None, None], (B, HEADS, L, 1))
    la_b = jnp.broadcast_to(log_g[1][None, :, None, None], (B, HEADS, L, 1))
    return (q, k, v, la_f), (q, k, v, la_b)


def retention_mixer(pc, pl, decay_logit, rot):
    B = pl['rt_q'].shape[0]
    init = jnp.zeros((B, HEADS, HEAD_DIM, HEAD_DIM), jnp.float32)
    c_f, c_b = retention_inputs(pc, decay_logit, None)
    l_f, l_b = retention_inputs(pl, decay_logit, rot)
    return bidir(chunk_linear, init, c_f, c_b, l_f, l_b)


def gla_inputs(p, w_a, b_a):
    q = to_heads(p['gl_q'])
    k = to_heads(p['gl_k']) * GLA_DK ** -0.5
    v = to_heads(p['gl_v'])

    def log_alpha(z, d):
        za = z.astype(jnp.float32) @ w_a[d].astype(jnp.float32) + b_a[d].astype(jnp.float32)
        return to_heads(jax.nn.log_sigmoid(za) / GLA_TAU)

    return (q, k, v, log_alpha(p['gl_a_fwd'], 0)), (q, k, v, log_alpha(p['gl_a_bwd'], 1))


def gla_mixer(pc, pl, w_a, b_a):
    B = pl['gl_q'].shape[0]
    init = jnp.zeros((B, HEADS, GLA_DK, HEAD_DIM), jnp.float32)
    c_f, c_b = gla_inputs(pc, w_a, b_a)
    l_f, l_b = gla_inputs(pl, w_a, b_a)
    return bidir(chunk_linear, init, c_f, c_b, l_f, l_b)


def out_gates(p):
    return jnp.concatenate([jax.nn.sigmoid(p['hg_g']), jax.nn.sigmoid(p['ml_o']),
                            jax.nn.silu(p['rt_g']), jax.nn.silu(p['gl_g'])], axis=-1)


def head_norm(y, g):
    B, L, _ = y.shape
    yh = y.astype(jnp.float32).reshape(B, L, N_HEADS_TOTAL, -1)
    yh = yh * lax.rsqrt(jnp.mean(yh * yh, axis=-1, keepdims=True) + RMS_EPS)
    return yh.reshape(B, L, -1) * g


def mixer_out(raw, p, g, w_o):
    return (head_norm(raw, g) * out_gates(p)).astype(p['hg_g'].dtype) @ w_o


def sq_relu_mlp(h, w1, w2):
    return jnp.square(jax.nn.relu(h @ w1)) @ w2


def setup_inputs(seed: int = 0) -> dict:
    key = jax.random.key(seed)
    ks = jax.random.split(key, 20)
    f32 = jnp.float32
    x = jax.random.normal(ks[0], (BATCH, SEQ, D_MODEL), f32)
    c = jax.random.normal(ks[1], (BATCH, D_MODEL), f32)
    ctx = jax.random.normal(ks[2], (BATCH, CTX_LEN, D_MODEL), f32)
    c_ctx = jax.random.normal(ks[3], (D_MODEL,), f32)
    w_ada = jax.random.normal(ks[4], (DEPTH, D_MODEL, 6 * D_MODEL), f32) * (0.5 * D_MODEL ** -0.5)
    b_ada = 0.01 * jax.random.normal(ks[5], (DEPTH, 6 * D_MODEL), f32)
    w_in = jax.random.normal(ks[6], (DEPTH, D_MODEL, IN_DIM), f32) * D_MODEL ** -0.5
    g_heads = 1.0 + 0.02 * jax.random.normal(ks[7], (DEPTH, D_MODEL), f32)
    hgrn_lb_logits = 0.5 * jax.random.normal(ks[8], (DEPTH, 2, GROUP_W), f32)
    ig_bias = 0.1 * jax.random.normal(ks[9], (DEPTH, 2, 1, HEADS), f32)
    fg_bias = jnp.linspace(3.0, 6.0, HEADS, dtype=f32)[None, None, None, :] + 0.1 * jax.random.normal(ks[10], (DEPTH, 2, 1, HEADS), f32)
    ml_gate_bias = jnp.concatenate([ig_bias, fg_bias], axis=2)
    rt_base = jnp.log(2.0 ** (5.0 + jnp.arange(HEADS, dtype=f32)) - 1.0)
    rt_decay_logit = rt_base[None, None, :] + 0.1 * jax.random.normal(ks[11], (DEPTH, 2, HEADS), f32)
    gla_w_a = jax.random.normal(ks[12], (DEPTH, 2, GLA_RANK, HEADS * GLA_DK), f32) * GLA_RANK ** -0.5
    gla_b_a = 0.1 * jax.random.normal(ks[13], (DEPTH, 2, HEADS * GLA_DK), f32)
    w_out = jax.random.normal(ks[14], (DEPTH, D_MODEL, D_MODEL), f32) * D_MODEL ** -0.5
    w_ff1 = jax.random.normal(ks[15], (DEPTH, D_MODEL, D_FF), f32) * D_MODEL ** -0.5
    w_ff2 = jax.random.normal(ks[16], (DEPTH, D_FF, D_MODEL), f32) * D_FF ** -0.5
    g_final = 1.0 + 0.02 * jax.random.normal(ks[17], (D_MODEL,), f32)
    return {'x': x, 'c': c, 'ctx': ctx, 'c_ctx': c_ctx, 'w_ada': w_ada, 'b_ada': b_ada,
            'w_in': w_in, 'g_heads': g_heads, 'hgrn_lb_logits': hgrn_lb_logits,
            'ml_gate_bias': ml_gate_bias, 'rt_decay_logit': rt_decay_logit,
            'gla_w_a': gla_w_a, 'gla_b_a': gla_b_a, 'w_out': w_out,
            'w_ff1': w_ff1, 'w_ff2': w_ff2, 'g_final': g_final}


def reference(x, c, ctx, c_ctx, w_ada, b_ada, w_in, g_heads, hgrn_lb_logits, ml_gate_bias,
              rt_decay_logit, gla_w_a, gla_b_a, w_out, w_ff1, w_ff2, g_final):
    ROWS = x.shape[1] // GRID_W
    rot = grid_rotary(ROWS)
    sm = jax.nn.softmax(hgrn_lb_logits.astype(jnp.float32), axis=0)
    lb_all = jnp.maximum(jnp.cumsum(sm, axis=0) - sm[:1], 0.0)
    xl, xc = x, ctx
    for layer in range(DEPTH):
        last = layer == DEPTH - 1
        mod_l = (jax.nn.silu(c) @ w_ada[layer] + b_ada[layer])[:, None, :]
        mod_c = (jax.nn.silu(c_ctx) @ w_ada[layer] + b_ada[layer])[None, None, :]
        sh1_l, sc1_l, g1_l, sh2_l, sc2_l, g2_l = jnp.split(mod_l, 6, axis=-1)
        sh1_c, sc1_c, g1_c, sh2_c, sc2_c, g2_c = jnp.split(mod_c, 6, axis=-1)
        pl = split_proj(modulate(xl, sh1_l, sc1_l) @ w_in[layer])
        pc = split_proj(modulate(xc, sh1_c, sc1_c) @ w_in[layer])
        mixed = (hgrn2_mixer(pc, pl, lb_all[layer]),
                 mlstm_mixer(pc, pl, ml_gate_bias[layer]),
                 retention_mixer(pc, pl, rt_decay_logit[layer], rot),
                 gla_mixer(pc, pl, gla_w_a[layer], gla_b_a[layer]))
        raw_l = jnp.concatenate([from_heads(m[1]) for m in mixed], axis=-1)
        xl = xl + g1_l * mixer_out(raw_l, pl, g_heads[layer], w_out[layer])
        if not last:
            raw_c = jnp.concatenate([from_heads(m[0]) for m in mixed], axis=-1)
            xc = xc + g1_c * mixer_out(raw_c, pc, g_heads[layer], w_out[layer])
        xl = xl + g2_l * sq_relu_mlp(modulate(xl, sh2_l, sc2_l), w_ff1[layer], w_ff2[layer])
        if not last:
            xc = xc + g2_c * sq_relu_mlp(modulate(xc, sh2_c, sc2_c), w_ff1[layer], w_ff2[layer])
    return rmsnorm(xl) * g_final
```

```cpp
#include <hip/hip_runtime.h>
#include <hip/hip_cooperative_groups.h>
#include <cstdio>
#include <cstdint>
namespace cgrp = cooperative_groups;
namespace pg8 {
#define PG8_LAS __attribute__((address_space(3)))
typedef unsigned short bf16_t;
typedef short bf16x8 __attribute__((ext_vector_type(8)));
typedef float f32x4 __attribute__((ext_vector_type(4)));
typedef unsigned u32x4 __attribute__((ext_vector_type(4)));
constexpr int BM = 256, BK = 64, HALF = 128, HTB = HALF * BK * 2  , STAGE_BYTES = 8 * HTB, NXCD = 8, WGM = 8;

__host__ __device__ __forceinline__ int lds_byte(int r, int c) { const int st = (r >> 4) * 2 + (c >> 5), rr = r & 15, cc = c & 31, ob = rr * 64 + cc * 2; return st * 1024 + (ob ^ (((ob >> 9) & 1) << 5)); }
__host__ __device__ __forceinline__ void stage_rc(int b, int& R, int& C) { const int st = b / 1024, sb = b % 1024, swz = sb ^ (((sb >> 9) & 1) << 5); R = (st >> 1) * 16 + swz / 64; C = (st & 1) * 32 + (swz % 64) / 2; }
__host__ __device__ __forceinline__ int perm32(int rho) { const int n = rho >> 4, i = rho & 15; return 8 * (i >> 2) + 4 * n + (i & 3); }

struct Unit { int pm, pn; };
struct Gemm { const bf16_t* A; const bf16_t* Bt; int M, N, K; };

struct StaticOrder {
    int nM, nN, nwg, G, c;
    __host__ __device__ void init(int M, int N, int G_, int c_) { nM = M / BM; nN = N / BM; nwg = nM * nN; G = G_; c = c_; }
    __host__ __device__ bool next(int i, Unit& u) const {
        const long L = (long)i * G + c; if (L >= nwg) return false;
        int wgid = (int)L; { const int q = nwg / NXCD, r = nwg % NXCD, xcd = wgid % NXCD, off = wgid / NXCD; wgid = (xcd < r ? xcd * (q + 1) : r * (q + 1) + (xcd - r) * q) + off; }
        const int nig = WGM * nN, gid = wgid / nig, fm = gid * WGM, gsz = (nM - fm) < WGM ? (nM - fm) : WGM;
        u.pm = fm + ((wgid % nig) % gsz); u.pn = (wgid % nig) / gsz; return true;
    }
    __device__ __forceinline__ void a_ready(const Unit&) const {}
    __device__ __forceinline__ void done(const Unit&) const {}
};

__device__ __forceinline__ unsigned cvt_pk_bf16(float lo, float hi) { unsigned r; asm volatile("v_cvt_pk_bf16_f32 %0, %1, %2" : "=v"(r) : "v"(lo), "v"(hi)); return r; }
typedef float f32x2 __attribute__((ext_vector_type(2)));
__device__ __forceinline__ f32x2 gelu_pk(f32x2 v) {
    const f32x2 av = __builtin_elementwise_abs(v), d = av * 0.2316418882f + 1.0f;
    f32x2 t; t.x = __builtin_amdgcn_rcpf(d.x); t.y = __builtin_amdgcn_rcpf(d.y);
    f32x2 q = t * 0.5307027145f + (-0.7265760135f); q = q * t + 0.7107068705f; q = q * t + (-0.142248368f); q = q * t + 0.127414796f; q = q * t;
    const f32x2 s = (v * v) * (-0.72134752044f);
    f32x2 e; e.x = __builtin_amdgcn_exp2f(s.x); e.y = __builtin_amdgcn_exp2f(s.y);
    const f32x2 m = v * (q * e), r = v - m;
    f32x2 o; o.x = v.x < 0.f ? m.x : r.x; o.y = v.y < 0.f ? m.y : r.y; return o;
}

template <int ACT  > struct EpiBf16 {
    static constexpr bool PERM = true, AFTER_DRAIN = false; static_assert(ACT == 0 || ACT == 1, "EpiBf16: ACT is 0 (none) or 1 (gelu_pk)");
    bf16_t* O; int ldc; const float* bias; int split_cols; size_t split_stride; float scale0;
    __device__ __forceinline__ void operator()(const f32x4 (&acc)[2][2][4][2], const Unit& u, int wr, int wc, int fr, int fq) const {
        const int row0 = u.pm * BM + wr * 64 + fr; int colt = u.pn * BM; bf16_t* base = O;
        float sc = 1.f; if (split_cols) { const int t = colt / split_cols; base += (size_t)t * split_stride; colt -= t * split_cols; if (t == 0) sc = scale0; }
        const int col0 = colt + wc * 32 + 8 * fq, bcol0 = u.pn * BM + wc * 32 + 8 * fq;
        f32x4 bv[2][2];
#pragma unroll
        for (int bj = 0; bj < 2; ++bj)
#pragma unroll
            for (int n = 0; n < 2; ++n) bv[bj][n] = bias ? *(const f32x4*)(bias + bcol0 + bj * HALF + 4 * n) : (f32x4){0.f, 0.f, 0.f, 0.f};
#pragma unroll
        for (int ai = 0; ai < 2; ++ai)
#pragma unroll
            for (int m = 0; m < 4; ++m) { bf16_t* rowp = base + (size_t)(row0 + ai * HALF + m * 16) * ldc + col0;
#pragma unroll
                for (int bj = 0; bj < 2; ++bj) { f32x4 v0 = acc[ai][bj][m][0] + bv[bj][0], v1 = acc[ai][bj][m][1] + bv[bj][1];
                    if (ACT == 1) { f32x2 a = gelu_pk((f32x2){v0[0], v0[1]}), b = gelu_pk((f32x2){v0[2], v0[3]}), c = gelu_pk((f32x2){v1[0], v1[1]}), d = gelu_pk((f32x2){v1[2], v1[3]});
                        v0 = (f32x4){a.x, a.y, b.x, b.y}; v1 = (f32x4){c.x, c.y, d.x, d.y}; }
                    v0 = v0 * sc; v1 = v1 * sc; u32x4 w; w.x = cvt_pk_bf16(v0[0], v0[1]); w.y = cvt_pk_bf16(v0[2], v0[3]); w.z = cvt_pk_bf16(v1[0], v1[1]); w.w = cvt_pk_bf16(v1[2], v1[3]);
                    *(u32x4*)(rowp + bj * HALF) = w; } }
    }
};
template <class Epi, class Sched, bool ALIGN_EPI = false, bool SP2 = false>
__device__ __forceinline__ void gemm_phase(PG8_LAS unsigned char* lds, const Gemm g, const Sched& S, const Epi& E) {
    int tid_ = threadIdx.x; asm volatile("" : "+v"(tid_)); const int tid = tid_, wid = __builtin_amdgcn_readfirstlane(tid >> 6), lane = tid & 63, wr = wid >> 2, wc = wid & 3, fr = lane & 15, fq = lane >> 4;
    const int K = g.K, nt = K / BK;
    unsigned voffA[2], voffB[2];
#pragma unroll
    for (int i = 0; i < 2; ++i) { int R, C; stage_rc(tid * 16 + i * 8192, R, C); const int Rb = Epi::PERM ? ((R & ~31) + perm32(R & 31)) : R;
        voffA[i] = (unsigned)(R * K + C) * 2u; voffB[i] = (unsigned)(Rb * K + C) * 2u; }
    const size_t kstep = (size_t)(BK * 2);
    const size_t hstep = (size_t)HALF * K * 2;
    const size_t tstep = 2 * hstep;
    const unsigned ldsw = (unsigned)wid * 1024u;
    const int aoff = lds_byte(wr * 64 + fr, fq * 8), boff = lds_byte(wc * 32 + fr, fq * 8);
#define PG8_SA(b, h) (((b) * 2 + (h)) * HTB)
#define PG8_SB(b, h) ((4 + (b) * 2 + (h)) * HTB)
#define PG8_STAGE(bufoff, gbase, voff) do { _Pragma("unroll") for (int _i = 0; _i < 2; ++_i) \
        __builtin_amdgcn_global_load_lds((const unsigned*)((const char*)(gbase) + (voff)[_i]), (PG8_LAS unsigned*)(lds + (bufoff) + ldsw + _i * 8192), 16, 0, 0); } while (0)
#define PG8_LDA(dst, b, h) do { _Pragma("unroll") for (int m = 0; m < 4; ++m) _Pragma("unroll") for (int k = 0; k < 2; ++k) dst[m][k] = *(const PG8_LAS bf16x8*)(lds + PG8_SA(b, h) + aoff + m * 2048 + k * 1024); } while (0)
#define PG8_LDB(dst, b, h) do { _Pragma("unroll") for (int n = 0; n < 2; ++n) _Pragma("unroll") for (int k = 0; k < 2; ++k) dst[n][k] = *(const PG8_LAS bf16x8*)(lds + PG8_SB(b, h) + boff + n * 2048 + k * 1024); } while (0)
#define PG8_MMA(ai, bj, At, Bt) do { __builtin_amdgcn_s_setprio(1); _Pragma("unroll") for (int m = 0; m < 4; ++m) _Pragma("unroll") for (int n = 0; n < 2; ++n) _Pragma("unroll") for (int k = 0; k < 2; ++k) \
        acc[ai][bj][m][n] = __builtin_amdgcn_mfma_f32_16x16x32_bf16(Bt[n][k], At[m][k], acc[ai][bj][m][n], 0, 0, 0); __builtin_amdgcn_s_setprio(0); } while (0)
#define PG8_WAIT_V(n) asm volatile("s_waitcnt vmcnt(" #n ")" ::: "memory")
#define PG8_WAIT_L(n) asm volatile("s_waitcnt lgkmcnt(" #n ")" ::: "memory")
#define PG8_BAR __builtin_amdgcn_s_barrier()
#define PG8_SCHED __builtin_amdgcn_sched_barrier(0)
    Unit cur, nxt; int ui = 0;
    if (!S.next(0, cur)) return;
    f32x4 acc[2][2][4][2];
#pragma unroll
    for (int a = 0; a < 2; ++a)
#pragma unroll
        for (int b = 0; b < 2; ++b)
#pragma unroll
            for (int m = 0; m < 4; ++m)
#pragma unroll
                for (int n = 0; n < 2; ++n) acc[a][b][m][n] = (f32x4){0.f, 0.f, 0.f, 0.f};
    bf16x8 At[4][2], B0[2][2], B1[2][2];
    const char* cA = (const char*)g.A + (size_t)cur.pm * tstep; const char* cB = (const char*)g.Bt + (size_t)cur.pn * tstep;
    S.a_ready(cur);
    if constexpr (SP2) {
        PG8_STAGE(PG8_SB(0, 0), cB, voffB); PG8_STAGE(PG8_SB(0, 1), cB + hstep, voffB); PG8_STAGE(PG8_SA(0, 0), cA, voffA); PG8_STAGE(PG8_SA(0, 1), cA + hstep, voffA);
        if (wr == 1) PG8_BAR;
        PG8_WAIT_V(2); PG8_BAR;
        PG8_STAGE(PG8_SB(1, 0), cB + kstep, voffB); PG8_STAGE(PG8_SA(1, 0), cA + kstep, voffA); PG8_STAGE(PG8_SB(1, 1), cB + hstep + kstep, voffB);
        PG8_WAIT_V(6); PG8_BAR;
    } else {
        PG8_STAGE(PG8_SB(0, 0), cB, voffB); PG8_STAGE(PG8_SA(0, 0), cA, voffA); PG8_STAGE(PG8_SB(0, 1), cB + hstep, voffB); PG8_STAGE(PG8_SA(0, 1), cA + hstep, voffA);
        if (wr == 1) PG8_BAR;
        PG8_WAIT_V(4); PG8_BAR;
        PG8_STAGE(PG8_SB(1, 0), cB + kstep, voffB); PG8_STAGE(PG8_SA(1, 0), cA + kstep, voffA); PG8_STAGE(PG8_SB(1, 1), cB + hstep + kstep, voffB);
        PG8_WAIT_V(6); PG8_BAR;
    }
    for (;;) {
        const bool has_next = S.next(ui + 1, nxt);
        const char* nA = has_next ? (const char*)g.A + (size_t)nxt.pm * tstep : cA; const char* nB = has_next ? (const char*)g.Bt + (size_t)nxt.pn * tstep : cB;
        for (int t = 0; t < nt; t += 2) {
            const bool last = (t == nt - 2);
            const char* a1 = cA + (size_t)(t + 1) * kstep;
            const char* a2 = last ? nA : cA + (size_t)(t + 2) * kstep; const char* b2 = last ? nB : cB + (size_t)(t + 2) * kstep;
            const char* a3 = a2 + kstep; const char* b3 = b2 + kstep;
            if (last && has_next) S.a_ready(nxt);
            if (last) E.prefetch(cur, wr, wc, fr, fq);
            if constexpr (SP2) {
            PG8_LDB(B0, 0, 0); PG8_LDB(B1, 0, 1); PG8_SCHED; PG8_LDA(At, 0, 0); PG8_STAGE(PG8_SA(1, 1), a1 + hstep, voffA);
            PG8_WAIT_V(8); PG8_WAIT_L(0); PG8_BAR; PG8_MMA(0, 0, At, B0); PG8_MMA(0, 1, At, B1); PG8_BAR; PG8_SCHED;
            PG8_LDA(At, 0, 1); PG8_STAGE(PG8_SB(0, 0), b2, voffB); PG8_STAGE(PG8_SB(0, 1), b2 + hstep, voffB); PG8_STAGE(PG8_SA(0, 0), a2, voffA);
            PG8_WAIT_V(8); PG8_WAIT_L(0); PG8_BAR; PG8_MMA(1, 0, At, B0); PG8_MMA(1, 1, At, B1); PG8_BAR; PG8_SCHED;
            PG8_LDB(B0, 1, 0); PG8_LDB(B1, 1, 1); PG8_SCHED; PG8_LDA(At, 1, 0); PG8_STAGE(PG8_SA(0, 1), a2 + hstep, voffA);
            PG8_WAIT_V(8); PG8_WAIT_L(0); PG8_BAR; PG8_MMA(0, 0, At, B0); PG8_MMA(0, 1, At, B1); PG8_BAR; PG8_SCHED;
            PG8_LDA(At, 1, 1); PG8_STAGE(PG8_SB(1, 0), b3, voffB); PG8_STAGE(PG8_SB(1, 1), b3 + hstep, voffB); PG8_STAGE(PG8_SA(1, 0), a3, voffA);
            PG8_WAIT_V(8); PG8_WAIT_L(0); PG8_BAR; PG8_MMA(1, 0, At, B0); PG8_MMA(1, 1, At, B1); PG8_BAR; PG8_SCHED;
            } else {
            PG8_LDB(B0, 0, 0); PG8_SCHED; PG8_LDA(At, 0, 0); PG8_STAGE(PG8_SA(1, 1), a1 + hstep, voffA);
            PG8_WAIT_L(8); PG8_BAR; PG8_WAIT_L(0); PG8_MMA(0, 0, At, B0); PG8_BAR; PG8_SCHED;
            PG8_LDB(B1, 0, 1); PG8_STAGE(PG8_SB(0, 0), b2, voffB);
            PG8_BAR; PG8_WAIT_L(0); PG8_MMA(0, 1, At, B1); PG8_BAR;
            PG8_LDA(At, 0, 1); PG8_STAGE(PG8_SA(0, 0), a2, voffA);
            PG8_BAR; PG8_WAIT_L(0); PG8_MMA(1, 0, At, B0); PG8_BAR; PG8_SCHED;
            PG8_STAGE(PG8_SB(0, 1), b2 + hstep, voffB);
            PG8_WAIT_V(6); PG8_BAR; PG8_MMA(1, 1, At, B1); PG8_BAR;
            PG8_LDB(B0, 1, 0); PG8_SCHED; PG8_LDA(At, 1, 0); PG8_STAGE(PG8_SA(0, 1), a2 + hstep, voffA);
            PG8_WAIT_L(8); PG8_BAR; PG8_WAIT_L(0); PG8_MMA(0, 0, At, B0); PG8_BAR; PG8_SCHED;
            PG8_LDB(B1, 1, 1); PG8_STAGE(PG8_SB(1, 0), b3, voffB);
            PG8_BAR; PG8_WAIT_L(0); PG8_MMA(0, 1, At, B1); PG8_BAR;
            PG8_LDA(At, 1, 1); PG8_STAGE(PG8_SA(1, 0), a3, voffA);
            PG8_BAR; PG8_WAIT_L(0); PG8_MMA(1, 0, At, B0); PG8_BAR; PG8_SCHED;
            PG8_STAGE(PG8_SB(1, 1), b3 + hstep, voffB);
            PG8_WAIT_V(6); PG8_BAR; PG8_MMA(1, 1, At, B1); PG8_BAR;
            }
        }
        if constexpr (ALIGN_EPI) { if (wr == 0) PG8_BAR; }
        if constexpr (!Epi::AFTER_DRAIN) { E(acc, cur, wr, wc, fr, fq); S.done(cur); }
        if (!has_next) break;
#pragma unroll
        for (int a = 0; a < 2; ++a)
#pragma unroll
            for (int b = 0; b < 2; ++b)
#pragma unroll
                for (int m = 0; m < 4; ++m)
#pragma unroll
                    for (int n = 0; n < 2; ++n) acc[a][b][m][n] = (f32x4){0.f, 0.f, 0.f, 0.f};
        cur = nxt; cA = nA; cB = nB; ++ui;
        if constexpr (ALIGN_EPI) { if (wr == 1) PG8_BAR; }
    }
    PG8_WAIT_V(0);
    if constexpr (!ALIGN_EPI) { if (wr == 0) PG8_BAR; }
    PG8_BAR;
    if constexpr (Epi::AFTER_DRAIN) { E.fused(acc, cur, wr, wc, fr, fq, lds, wid, lane); S.done(cur); }
#undef PG8_SA
#undef PG8_SB
#undef PG8_STAGE
#undef PG8_LDA
#undef PG8_LDB
#undef PG8_MMA
#undef PG8_WAIT_V
#undef PG8_WAIT_L
#undef PG8_BAR
#undef PG8_SCHED
}
}

#define LAS __attribute__((address_space(3)))
typedef unsigned short bf16;
typedef float f32x4 __attribute__((ext_vector_type(4)));
typedef short bf16x8 __attribute__((ext_vector_type(8)));
typedef unsigned u32x4 __attribute__((ext_vector_type(4)));
typedef unsigned u32x2 __attribute__((ext_vector_type(2)));

#ifndef MK_MULTI
#define MK_MULTI 0
#endif

constexpr int DM = 1024, NB = 8, SEQ = 8192, CTXL = 256, DFF = 4096;
constexpr int MLAT = NB * SEQ, MCTX = NB * CTXL, MALL = MLAT + MCTX;
constexpr int IN_DIM = 4144, INP = 4352;
constexpr int MODW = 6 * DM;
constexpr float EPS = 1e-6f;
constexpr int C_HG_Q = 0, C_HG_FF = 256, C_HG_FB = 512, C_HG_I = 768, C_HG_G = 1024, C_ML_Q = 1280, C_ML_K = 1536, C_ML_V = 1792, C_ML_IF = 2048, C_ML_O = 2064,
              C_RT_Q = 2320, C_RT_K = 2576, C_RT_V = 2832, C_RT_G = 3088, C_GL_Q = 3344, C_GL_K = 3472, C_GL_V = 3600, C_GL_AF = 3856, C_GL_AB = 3872, C_GL_G = 3888;
static_assert(C_GL_G + 256 == IN_DIM, "layout");

constexpr size_t MiB = 1u << 20;
constexpr size_t WIN_BYTES = (size_t)INP * DM * 2;
constexpr size_t WS_WIN = 2 * MiB, WS_WOUT = 20 * MiB, WS_WFF1 = 24 * MiB, WS_WFF2 = 40 * MiB, WS_MOD = 56 * MiB, WS_XC = 58 * MiB;
constexpr size_t WS_H = 66 * MiB;
constexpr size_t WS_YF = 198 * MiB;
constexpr size_t WS_P = 330 * MiB;
static_assert(WS_WIN + 2 * WIN_BYTES <= WS_WOUT, "ws map");
constexpr int LDS_BYTES = 147456;
constexpr int NPHASE = 15;
constexpr size_t WS_BIAS = 1 * MiB;
constexpr size_t WS_SS1 = 57 * MiB, WS_SS2 = WS_SS1 + 512 * 1024;

struct Params {
    const float *x, *c, *ctx, *c_ctx, *w_ada, *b_ada, *w_in, *g_heads, *lb_logits, *ml_bias, *rt_logit, *gla_w, *gla_b, *w_out, *w_ff1, *w_ff2, *g_final;
    float* out; unsigned char* ws; int ph_lo, ph_hi;
};

typedef __bf16 bf16x2v_ __attribute__((ext_vector_type(2)));
typedef float f32x2v_ __attribute__((ext_vector_type(2)));
__device__ __forceinline__ unsigned pk_bf16(float lo, float hi) { const f32x2v_ v = {lo, hi}; const bf16x2v_ b = __builtin_convertvector(v, bf16x2v_); return __builtin_bit_cast(unsigned, b); }
__device__ __forceinline__ void unpack8(const u32x4 w, float (&f)[8]) {
    f[0] = __uint_as_float(w.x << 16); f[1] = __uint_as_float(w.x & 0xffff0000u); f[2] = __uint_as_float(w.y << 16); f[3] = __uint_as_float(w.y & 0xffff0000u);
    f[4] = __uint_as_float(w.z << 16); f[5] = __uint_as_float(w.z & 0xffff0000u); f[6] = __uint_as_float(w.w << 16); f[7] = __uint_as_float(w.w & 0xffff0000u);
}
__device__ __forceinline__ u32x4 pack8(const float (&f)[8]) { u32x4 o; o.x = pk_bf16(f[0], f[1]); o.y = pk_bf16(f[2], f[3]); o.z = pk_bf16(f[4], f[5]); o.w = pk_bf16(f[6], f[7]); return o; }
__device__ __forceinline__ float wave_sum(float v) {
#pragma unroll
    for (int o = 1; o < 64; o <<= 1) v += __shfl_xor(v, o);
    return v;
}
__device__ __forceinline__ int tid_opaque() { int t = threadIdx.x; asm volatile("" : "+v"(t)); return t; }
__device__ __forceinline__ float sigmoidf_(float z) { return __builtin_amdgcn_rcpf(1.f + __expf(-z)); }
__device__ __forceinline__ float logsigmoidf_(float z) { return fminf(z, 0.f) - __logf(1.f + __expf(-fabsf(z))); }

template <int ACT, int LDC> struct EpiAct {
    static constexpr bool PERM = true, AFTER_DRAIN = false;
    bf16* O;
    __device__ __forceinline__ void operator()(const pg8::f32x4 (&acc)[2][2][4][2], const pg8::Unit& u, int wr, int wc, int fr, int fq) const {
        const int row0 = u.pm * 256 + wr * 64 + fr, col0 = u.pn * 256 + wc * 32 + 8 * fq;
#pragma unroll
        for (int ai = 0; ai < 2; ++ai)
#pragma unroll
            for (int m = 0; m < 4; ++m) { bf16* rowp = O + (size_t)(row0 + ai * 128 + m * 16) * LDC + col0;
#pragma unroll
                for (int bj = 0; bj < 2; ++bj) { pg8::f32x4 v0 = acc[ai][bj][m][0], v1 = acc[ai][bj][m][1];
                    if (ACT == 1) {
#pragma unroll
                        for (int j = 0; j < 4; ++j) { float a = fmaxf(v0[j], 0.f), b = fmaxf(v1[j], 0.f); v0[j] = a * a; v1[j] = b * b; } }
                    u32x4 w; w.x = pk_bf16(v0[0], v0[1]); w.y = pk_bf16(v0[2], v0[3]); w.z = pk_bf16(v1[0], v1[1]); w.w = pk_bf16(v1[2], v1[3]);
                    *(u32x4*)(rowp + bj * 128) = w; } }
    }
};
struct EpiResNorm {
    static constexpr bool PERM = false, AFTER_DRAIN = false;
    const float* base_lat; const float* base_ctx; float* out_lat; float* out_ctx; const float* gate; const float* scale; bf16* H; float* ss; int store_f32;
    __device__ __forceinline__ void prefetch(const pg8::Unit&, int, int, int, int) const {}
    __device__ __forceinline__ void operator()(const pg8::f32x4 (&acc)[2][2][4][2], const pg8::Unit& u, int wr, int wc, int fr, int fq) const {
        const bool isc = u.pm >= 256; const int pmr = isc ? u.pm - 256 : u.pm;
        const float* bp = isc ? base_ctx : base_lat; float* op = isc ? out_ctx : out_lat;
        const int col0 = u.pn * 256 + wc * 32 + 4 * fq;
        const size_t off0 = (size_t)(pmr * 256 + wr * 64 + fr) * DM + col0, grow0 = (size_t)u.pm * 256 + wr * 64 + fr;
        const int brow = isc ? 8 : (u.pm >> 5);
        f32x4 gv[2][2], sv[2][2];
#pragma unroll
        for (int bj = 0; bj < 2; ++bj)
#pragma unroll
            for (int n = 0; n < 2; ++n) { gv[bj][n] = *(const f32x4*)(gate + brow * MODW + col0 + bj * 128 + n * 16); sv[bj][n] = scale ? *(const f32x4*)(scale + brow * MODW + col0 + bj * 128 + n * 16) : (f32x4){0.f, 0.f, 0.f, 0.f}; }
        f32x4 cur[2][2], nxt[2][2];
#pragma unroll
        for (int bj = 0; bj < 2; ++bj)
#pragma unroll
            for (int n = 0; n < 2; ++n) cur[bj][n] = *(const f32x4*)(bp + off0 + bj * 128 + n * 16);
#pragma unroll
        for (int g = 0; g < 8; ++g) { const int rl = (g >> 2) * 128 + (g & 3) * 16; const size_t off = off0 + (size_t)rl * DM, grow = grow0 + rl;
            if (g < 7) { const int rl2 = ((g + 1) >> 2) * 128 + ((g + 1) & 3) * 16;
#pragma unroll
                for (int bj = 0; bj < 2; ++bj)
#pragma unroll
                    for (int n = 0; n < 2; ++n) nxt[bj][n] = *(const f32x4*)(bp + off0 + (size_t)rl2 * DM + bj * 128 + n * 16); }
            asm volatile("" ::: "memory");
            float sq = 0.f;
#pragma unroll
            for (int bj = 0; bj < 2; ++bj)
#pragma unroll
                for (int n = 0; n < 2; ++n) { const f32x4 o = cur[bj][n] + gv[bj][n] * acc[g >> 2][bj][g & 3][n];
                    if (store_f32) *(f32x4*)(op + off + bj * 128 + n * 16) = o; sq += (o.x * o.x + o.y * o.y) + (o.z * o.z + o.w * o.w);
                    if (H) { const f32x4 xs = o * (sv[bj][n] + 1.f); u32x2 wv; wv.x = pk_bf16(xs.x, xs.y); wv.y = pk_bf16(xs.z, xs.w); *(u32x2*)(H + grow * DM + col0 + bj * 128 + n * 16) = wv; } }
            sq += __shfl_xor(sq, 16); sq += __shfl_xor(sq, 32);
            if (fq == 0) atomicAdd(ss + grow, sq);
            asm volatile("" ::: "memory");
#pragma unroll
            for (int bj = 0; bj < 2; ++bj)
#pragma unroll
                for (int n = 0; n < 2; ++n) cur[bj][n] = nxt[bj][n]; }
    }
};
template <int ACT, int LDC> struct EpiNormAct {
    static constexpr bool PERM = true, AFTER_DRAIN = false;
    bf16* O; const float* ss; const float* bias;
    mutable float rs[8];
    __device__ __forceinline__ void prefetch(const pg8::Unit& u, int wr, int wc, int fr, int fq) const {
        const int row0 = u.pm * 256 + wr * 64 + fr, col0 = u.pn * 256 + wc * 32 + 8 * fq;
#pragma unroll
        for (int i = 0; i < 8; ++i) rs[i] = ss[row0 + (i >> 2) * 128 + (i & 3) * 16];
    }
    __device__ __forceinline__ void operator()(const pg8::f32x4 (&acc)[2][2][4][2], const pg8::Unit& u, int wr, int wc, int fr, int fq) const {
        const int row0 = u.pm * 256 + wr * 64 + fr, col0 = u.pn * 256 + wc * 32 + 8 * fq;
        const float* bp = bias + (u.pm >= 256 ? 8 : (u.pm >> 5)) * INP + col0;
        f32x4 bv[2][2];
#pragma unroll
        for (int bj = 0; bj < 2; ++bj) { bv[bj][0] = *(const f32x4*)(bp + bj * 128); bv[bj][1] = *(const f32x4*)(bp + bj * 128 + 4); }
#pragma unroll
        for (int ai = 0; ai < 2; ++ai)
#pragma unroll
            for (int m = 0; m < 4; ++m) { const int row = row0 + ai * 128 + m * 16; const float r = rsqrtf(rs[ai * 4 + m] * (1.f / DM) + EPS); bf16* rowp = O + (size_t)row * LDC + col0;
#pragma unroll
                for (int bj = 0; bj < 2; ++bj) { pg8::f32x4 v0 = acc[ai][bj][m][0] * r + bv[bj][0], v1 = acc[ai][bj][m][1] * r + bv[bj][1];
                    if (ACT == 1) {
#pragma unroll
                        for (int j = 0; j < 4; ++j) { float a = fmaxf(v0[j], 0.f), b = fmaxf(v1[j], 0.f); v0[j] = a * a; v1[j] = b * b; } }
                    u32x4 w; w.x = pk_bf16(v0[0], v0[1]); w.y = pk_bf16(v0[2], v0[3]); w.z = pk_bf16(v1[0], v1[1]); w.w = pk_bf16(v1[2], v1[3]);
                    *(u32x4*)(rowp + bj * 128) = w; } }
    }
};

__device__ __forceinline__ void transpose_item(const float* W, int K, int N, int Npad, bf16* WT, LAS float* scr, int item, int lane) {
    const int nblk = Npad / 32, kb = item / nblk, nb = item % nblk, k0 = 64 * kb, n0 = 32 * nb;
    const int n = n0 + (lane & 31);
    float wv[32];
#pragma unroll
    for (int i = 0; i < 32; ++i) { const int kk = 2 * i + (lane >> 5); wv[i] = n < N ? W[(size_t)(k0 + kk) * N + n] : 0.f; }
#pragma unroll
    for (int i = 0; i < 32; ++i) { const int kk = 2 * i + (lane >> 5); scr[kk * 33 + (lane & 31)] = wv[i]; }
    asm volatile("s_waitcnt lgkmcnt(0)" ::: "memory");
    const int c = lane & 7;
#pragma unroll
    for (int j = 0; j < 4; ++j) { const int nn = (lane >> 3) + 8 * j; const LAS float* s = scr + (8 * c) * 33 + nn;
        u32x4 o; o.x = pk_bf16(s[0 * 33], s[1 * 33]); o.y = pk_bf16(s[2 * 33], s[3 * 33]); o.z = pk_bf16(s[4 * 33], s[5 * 33]); o.w = pk_bf16(s[6 * 33], s[7 * 33]);
        *(u32x4*)(WT + (size_t)(n0 + nn) * K + k0 + 8 * c) = o; }
    asm volatile("s_waitcnt lgkmcnt(0)" ::: "memory");
}
__device__ __forceinline__ void mod_gemv_phase(const Params& p, LAS unsigned char* lds, const int lsel, const int first_blk) {
    const int tid = tid_opaque(), lane = tid & 63, wave = tid >> 6;
    LAS float* scs = (LAS float*)lds;
    LAS float* part = (LAS float*)(lds + 36864);
    float* mod = (float*)(p.ws + WS_MOD);
    if ((int)blockIdx.x < first_blk) return;
    bool staged = false;
    for (int item = (int)blockIdx.x - first_blk; item < 96; item += (int)gridDim.x - first_blk) {
        if (!staged) { __syncthreads(); for (int i = tid; i < 9 * 1024; i += 512) { const int r = i >> 10, k = i & 1023; const float v = r < 8 ? p.c[r * 1024 + k] : p.c_ctx[k]; scs[i] = v / (1.f + __expf(-v)); } __syncthreads(); staged = true; }
        const int l = lsel, n0 = item * 64;
        const float* W = p.w_ada + (size_t)l * DM * MODW + n0 + lane;
        float acc[9];
#pragma unroll
        for (int r = 0; r < 9; ++r) acc[r] = 0.f;
        const int k0 = wave * 128;
#pragma unroll 16
        for (int k = k0; k < k0 + 128; ++k) { const float wv = W[(size_t)k * MODW];
#pragma unroll
            for (int r = 0; r < 9; ++r) acc[r] += scs[r * 1024 + k] * wv; }
#pragma unroll
        for (int r = 0; r < 9; ++r) part[(wave * 9 + r) * 64 + lane] = acc[r];
        __syncthreads();
        for (int i = tid; i < 576; i += 512) { const int r = i >> 6, ln = i & 63; float s = p.b_ada[l * MODW + n0 + ln];
#pragma unroll
            for (int w2 = 0; w2 < 8; ++w2) s += part[(w2 * 9 + r) * 64 + ln];
            mod[(size_t)(l * 9 + r) * MODW + n0 + ln] = s; }
        __syncthreads();
    }
    __syncthreads();
}
__device__ __forceinline__ void prologue_phase(const Params& p, LAS unsigned char* lds) {
    mod_gemv_phase(p, lds, 0, 0);
    const int tid = tid_opaque(), lane = tid & 63, wave = tid >> 6;
    LAS float* scr = (LAS float*)(lds + wave * 16384);
    constexpr int I_IN = 16 * (INP / 32), I_OUT = 16 * 32, I_F1 = 16 * (DFF / 32), I_F2 = (DFF / 64) * 32, PER_L = I_IN + I_OUT + I_F1 + I_F2;
    constexpr int NA = 5632;
    const int G = (int)gridDim.x, bx = (int)blockIdx.x;
    const int nA = G > 96 ? NA : 0;
    for (int pass = 0; pass < 2; ++pass) {
        int it0, step, lim;
        if (pass == 0) { if (bx < 96 || nA == 0) continue; it0 = (bx - 96) * 8 + wave; step = (G - 96) * 8; lim = nA; }
        else { it0 = nA + bx * 8 + wave; step = G * 8; lim = PER_L; }
        for (int it = it0; it < lim; it += step) {
            const int l = 0; int r = it;
            if (r < I_IN) { transpose_item(p.w_in + (size_t)l * DM * IN_DIM, DM, IN_DIM, INP, (bf16*)(p.ws + WS_WIN + l * WIN_BYTES), scr, r, lane); continue; } r -= I_IN;
            if (r < I_OUT) { transpose_item(p.w_out + (size_t)l * DM * DM, DM, DM, DM, (bf16*)(p.ws + WS_WOUT + l * 2 * MiB), scr, r, lane); continue; } r -= I_OUT;
            if (r < I_F1) { transpose_item(p.w_ff1 + (size_t)l * DM * DFF, DM, DFF, DFF, (bf16*)(p.ws + WS_WFF1 + l * 8 * MiB), scr, r, lane); continue; } r -= I_F1;
            transpose_item(p.w_ff2 + (size_t)l * DFF * DM, DFF, DM, DM, (bf16*)(p.ws + WS_WFF2 + l * 8 * MiB), scr, r, lane);
        }
    }
}
__device__ __forceinline__ void prep_layer1_weights(const Params& p, LAS unsigned char* lds, int first_blk) {
    const int tid = tid_opaque(), lane = tid & 63, wave = tid >> 6;
    if ((int)blockIdx.x < first_blk) return;
    LAS float* scr = (LAS float*)(lds + wave * 16384);
    const int gw = ((int)blockIdx.x - first_blk) * 8 + wave, NGW = ((int)gridDim.x - first_blk) * 8;
    constexpr int I_IN = 16 * (INP / 32), I_OUT = 16 * 32, I_F1 = 16 * (DFF / 32), I_F2 = (DFF / 64) * 32, PER_L = I_IN + I_OUT + I_F1 + I_F2;
    const int l = 1;
    for (int it = gw; it < PER_L; it += NGW) {
        int r = it;
        if (r < I_IN) { transpose_item(p.w_in + (size_t)l * DM * IN_DIM, DM, IN_DIM, INP, (bf16*)(p.ws + WS_WIN + l * WIN_BYTES), scr, r, lane); continue; } r -= I_IN;
        if (r < I_OUT) { transpose_item(p.w_out + (size_t)l * DM * DM, DM, DM, DM, (bf16*)(p.ws + WS_WOUT + l * 2 * MiB), scr, r, lane); continue; } r -= I_OUT;
        if (r < I_F1) { transpose_item(p.w_ff1 + (size_t)l * DM * DFF, DM, DFF, DFF, (bf16*)(p.ws + WS_WFF1 + l * 8 * MiB), scr, r, lane); continue; } r -= I_F1;
        transpose_item(p.w_ff2 + (size_t)l * DFF * DM, DFF, DM, DM, (bf16*)(p.ws + WS_WFF2 + l * 8 * MiB), scr, r, lane);
    }
}
__device__ __forceinline__ void init_scale_phase(const float* src_lat, const float* src_ctx, const float* modl, int scoff, bf16* H, float* ss) {
    const int tid = tid_opaque(), lane = tid & 63, gw = blockIdx.x * 8 + (tid >> 6), NGW = gridDim.x * 8;
    for (int m0 = gw * 4; m0 < MALL; m0 += NGW * 4) {
        const float* xr = m0 < MLAT ? src_lat + (size_t)m0 * DM : src_ctx + (size_t)(m0 - MLAT) * DM;
        const float* mr = modl + (m0 < MLAT ? (m0 >> 13) : 8) * MODW;
        f32x4 v[4][4];
#pragma unroll
        for (int rr = 0; rr < 4; ++rr)
#pragma unroll
            for (int j = 0; j < 4; ++j) v[rr][j] = ((const f32x4*)(xr + (size_t)rr * DM))[64 * j + lane];
        f32x4 sc[4];
#pragma unroll
        for (int j = 0; j < 4; ++j) sc[j] = *(const f32x4*)(mr + scoff + 256 * j + 4 * lane) + 1.f;
#pragma unroll
        for (int rr = 0; rr < 4; ++rr) { float sq = 0.f;
#pragma unroll
            for (int j = 0; j < 4; ++j) sq += (v[rr][j].x * v[rr][j].x + v[rr][j].y * v[rr][j].y) + (v[rr][j].z * v[rr][j].z + v[rr][j].w * v[rr][j].w);
            sq = wave_sum(sq); if (lane == 0) ss[m0 + rr] = sq;
#pragma unroll
            for (int j = 0; j < 4; ++j) { const f32x4 o = v[rr][j] * sc[j]; u32x2 wv; wv.x = pk_bf16(o.x, o.y); wv.y = pk_bf16(o.z, o.w); *(u32x2*)(H + (size_t)(m0 + rr) * DM + 256 * j + 4 * lane) = wv; } }
    }
}
__device__ __forceinline__ void bias_gemv_phase(const Params& p, LAS unsigned char* lds, const int lsel, const int first_blk) {
    const int tid = tid_opaque(), lane = tid & 63, wave = tid >> 6;
    LAS float* shs = (LAS float*)lds;
    LAS float* part = (LAS float*)(lds + 36864);
    const float* mod = (const float*)(p.ws + WS_MOD); float* bias = (float*)(p.ws + WS_BIAS);
    if ((int)blockIdx.x < first_blk) return;
    for (int item = (int)blockIdx.x - first_blk; item < 132; item += (int)gridDim.x - first_blk) {
        const int l = lsel, r0 = item, which = r0 < 68 ? 0 : 1, grp = which ? r0 - 68 : r0, n0 = grp * 64;
        const int N = which ? DFF : IN_DIM, shoff = which ? 3 * DM : 0;
        const float* W = which ? p.w_ff1 + (size_t)l * DM * DFF : p.w_in + (size_t)l * DM * IN_DIM;
        __syncthreads();
        for (int i = tid; i < 9 * 1024; i += 512) shs[i] = mod[(size_t)(l * 9 + (i >> 10)) * MODW + shoff + (i & 1023)];
        __syncthreads();
        const int n = n0 + lane; const bool valid = n < N;
        float acc[9];
#pragma unroll
        for (int r = 0; r < 9; ++r) acc[r] = 0.f;
        const int k0 = wave * 128;
        if (n0 < N) {
#pragma unroll 16
            for (int k = k0; k < k0 + 128; ++k) { const float wv = valid ? W[(size_t)k * N + n] : 0.f;
#pragma unroll
                for (int r = 0; r < 9; ++r) acc[r] += shs[r * 1024 + k] * wv; } }
#pragma unroll
        for (int r = 0; r < 9; ++r) part[(wave * 9 + r) * 64 + lane] = acc[r];
        __syncthreads();
        for (int i = tid; i < 576; i += 512) { const int r = i >> 6, ln = i & 63; float sm = 0.f;
#pragma unroll
            for (int w2 = 0; w2 < 8; ++w2) sm += part[(w2 * 9 + r) * 64 + ln];
            bias[(size_t)((l * 2 + which) * 9 + r) * INP + n0 + ln] = sm; }
    }
    __syncthreads();
}
__device__ __forceinline__ void norm_phase(const float* src_lat, const float* src_ctx, const float* modl, int shoff, int scoff, bf16* H, int nrows) {
    const int tid = tid_opaque(), lane = tid & 63, gw = blockIdx.x * 8 + (tid >> 6), NGW = gridDim.x * 8;
    for (int m0 = gw * 4; m0 < nrows; m0 += NGW * 4) {
        const float* xr = m0 < MLAT ? src_lat + (size_t)m0 * DM : src_ctx + (size_t)(m0 - MLAT) * DM;
        const float* mr = modl + (m0 < MLAT ? (m0 >> 13) : 8) * MODW;
        f32x4 v[4][4];
#pragma unroll
        for (int rr = 0; rr < 4; ++rr)
#pragma unroll
            for (int j = 0; j < 4; ++j) v[rr][j] = ((const f32x4*)(xr + (size_t)rr * DM))[64 * j + lane];
        f32x4 sh[4], sc[4];
#pragma unroll
        for (int j = 0; j < 4; ++j) { const int col = 256 * j + 4 * lane; sh[j] = *(const f32x4*)(mr + shoff + col); sc[j] = *(const f32x4*)(mr + scoff + col) + 1.f; }
#pragma unroll
        for (int rr = 0; rr < 4; ++rr) { float ss = 0.f;
#pragma unroll
            for (int j = 0; j < 4; ++j) ss += (v[rr][j].x * v[rr][j].x + v[rr][j].y * v[rr][j].y) + (v[rr][j].z * v[rr][j].z + v[rr][j].w * v[rr][j].w);
            const float r = rsqrtf(wave_sum(ss) * (1.f / DM) + EPS);
#pragma unroll
            for (int j = 0; j < 4; ++j) { const int col = 256 * j + 4 * lane; const f32x4 o = v[rr][j] * r * sc[j] + sh[j];
                u32x2 wv; wv.x = pk_bf16(o.x, o.y); wv.y = pk_bf16(o.z, o.w); *(u32x2*)(H + (size_t)(m0 + rr) * DM + col) = wv; } }
    }
}
__device__ __forceinline__ void final_norm_phase(float* xo, const bf16* xb, const float* gfin, const float* ss) {
    const int tid = tid_opaque(), lane = tid & 63, gw = blockIdx.x * 8 + (tid >> 6), NGW = gridDim.x * 8;
    f32x4 g[4];
#pragma unroll
    for (int j = 0; j < 4; ++j) g[j] = ((const f32x4*)gfin)[64 * j + lane];
    for (int m0 = gw * 4; m0 < MLAT; m0 += NGW * 4) {
        u32x2 v[4][4]; float r[4];
#pragma unroll
        for (int rr = 0; rr < 4; ++rr) { r[rr] = rsqrtf(ss[m0 + rr] * (1.f / DM) + EPS);
#pragma unroll
            for (int j = 0; j < 4; ++j) v[rr][j] = *(const u32x2*)(xb + (size_t)(m0 + rr) * DM + 256 * j + 4 * lane); }
#pragma unroll
        for (int rr = 0; rr < 4; ++rr)
#pragma unroll
            for (int j = 0; j < 4; ++j) { const u32x2 w = v[rr][j];
                const f32x4 x = {__uint_as_float(w.x << 16), __uint_as_float(w.x & 0xffff0000u), __uint_as_float(w.y << 16), __uint_as_float(w.y & 0xffff0000u)};
                ((f32x4*)(xo + (size_t)(m0 + rr) * DM))[64 * j + lane] = x * r[rr] * g[j]; }
    }
}
__device__ __forceinline__ void gate_phase(const Params& p, int layer, int nrows) {
    const int tid = tid_opaque(), lane = tid & 63, gw = blockIdx.x * 8 + (tid >> 6), NGW = gridDim.x * 8;
    bf16* YF = (bf16*)(p.ws + WS_YF); const bf16* YB = (const bf16*)(p.ws + WS_H); const bf16* P = (const bf16*)(p.ws + WS_P);
    const float* gh = p.g_heads + layer * DM;
    { float* ss1 = (float*)(p.ws + WS_SS1); float* ss2 = (float*)(p.ws + WS_SS2); for (int i = blockIdx.x * 512 + tid; i < MALL; i += gridDim.x * 512) { ss1[i] = 0.f; ss2[i] = 0.f; } }
    float ghv[2][8];
#pragma unroll
    for (int g2 = 0; g2 < 2; ++g2) { const int c = g2 * 512 + lane * 8; const f32x4 g0 = *(const f32x4*)(gh + c), g1 = *(const f32x4*)(gh + c + 4);
        ghv[g2][0] = g0.x; ghv[g2][1] = g0.y; ghv[g2][2] = g0.z; ghv[g2][3] = g0.w; ghv[g2][4] = g1.x; ghv[g2][5] = g1.y; ghv[g2][6] = g1.z; ghv[g2][7] = g1.w; }
    for (int m0 = gw * 2; m0 < nrows; m0 += NGW * 2) {
        u32x4 a[2][2], b[2][2], gt[2][2];
#pragma unroll
        for (int rr = 0; rr < 2; ++rr)
#pragma unroll
            for (int g2 = 0; g2 < 2; ++g2) { const int c = g2 * 512 + lane * 8, mix = c >> 8; const size_t m = (size_t)(m0 + rr);
                const int gcol = (mix == 0 ? C_HG_G : mix == 1 ? C_ML_O : mix == 2 ? C_RT_G : C_GL_G) + (c & 255);
                a[rr][g2] = *(const u32x4*)(YF + m * DM + c); b[rr][g2] = *(const u32x4*)(YB + m * DM + c); gt[rr][g2] = *(const u32x4*)(P + m * INP + gcol); }
#pragma unroll
        for (int rr = 0; rr < 2; ++rr)
#pragma unroll
            for (int g2 = 0; g2 < 2; ++g2) { const int c = g2 * 512 + lane * 8, mix = c >> 8;
                float ya[8], yb[8], gg[8], o[8]; unpack8(a[rr][g2], ya); unpack8(b[rr][g2], yb); unpack8(gt[rr][g2], gg);
                float ss = 0.f;
#pragma unroll
                for (int e = 0; e < 8; ++e) { ya[e] += yb[e]; ss += ya[e] * ya[e]; }
                ss += __shfl_xor(ss, 1); ss += __shfl_xor(ss, 2); ss += __shfl_xor(ss, 4);
                const float r = rsqrtf(ss * (1.f / 64.f) + EPS);
#pragma unroll
                for (int e = 0; e < 8; ++e) { const float sg = sigmoidf_(gg[e]); const float gate = mix < 2 ? sg : gg[e] * sg; o[e] = ya[e] * r * ghv[g2][e] * gate; }
                *(u32x4*)(YF + (size_t)(m0 + rr) * DM + c) = pack8(o); }
    }
}

constexpr int RS = 72;
constexpr int L_BUF = 46336, L_QM = 0, L_QD = 9216, L_KM = 18432, L_KET = 27648, L_VT = 36864, L_DL = 46080;
constexpr int L_ST = 92672, L_AT = 111104, L_DEN = 120320, L_NST = 120576, L_WA = 120832, L_BA = 122880, L_LB = 123136, L_COLC = 123392, L_COLS = 127488, L_ROWT = 131584;
static_assert(L_ROWT + 256 <= LDS_BYTES - 128, "scan LDS map");
__device__ __forceinline__ void sincos_red(float pos, float inv, float& sn, float& cs) {
    const float angf = pos * inv; const float n = rintf(angf * 0.15915494309189535f);
    float y = fmaf(-n, 6.28125f, angf); y = fmaf(-n, 1.9353071795864769e-3f, y);
    sn = __sinf(y); cs = __cosf(y);
}
__device__ __forceinline__ unsigned short bf1(float x) { return (unsigned short)(pk_bf16(x, 0.f) & 0xffffu); }
__device__ __forceinline__ float rdlane(float v, int l) { return __int_as_float(__builtin_amdgcn_readlane(__float_as_int(v), l)); }
#define DPPF(x, ctrl, rmask) __int_as_float(__builtin_amdgcn_update_dpp(0, __float_as_int(x), (ctrl), (rmask), 0xf, false))
__device__ __forceinline__ float wave_incl_scan(float x) {
    x += DPPF(x, 0x111, 0xf); x += DPPF(x, 0x112, 0xf); x += DPPF(x, 0x114, 0xf); x += DPPF(x, 0x118, 0xf);
    x += DPPF(x, 0x142, 0xa); x += DPPF(x, 0x143, 0xc);
    return x;
}
__device__ __forceinline__ void wave_incl_scan8(float (&x)[8]) {
#pragma unroll
    for (int e = 0; e < 8; ++e) x[e] += DPPF(x[e], 0x111, 0xf);
#pragma unroll
    for (int e = 0; e < 8; ++e) x[e] += DPPF(x[e], 0x112, 0xf);
#pragma unroll
    for (int e = 0; e < 8; ++e) x[e] += DPPF(x[e], 0x114, 0xf);
#pragma unroll
    for (int e = 0; e < 8; ++e) x[e] += DPPF(x[e], 0x118, 0xf);
#pragma unroll
    for (int e = 0; e < 8; ++e) x[e] += DPPF(x[e], 0x142, 0xa);
#pragma unroll
    for (int e = 0; e < 8; ++e) x[e] += DPPF(x[e], 0x143, 0xc);
}
template <int N> __device__ __forceinline__ void wave_incl_scanN(float (&x)[8]) {
#pragma unroll
    for (int e = 0; e < N; ++e) x[e] += DPPF(x[e], 0x111, 0xf);
#pragma unroll
    for (int e = 0; e < N; ++e) x[e] += DPPF(x[e], 0x112, 0xf);
#pragma unroll
    for (int e = 0; e < N; ++e) x[e] += DPPF(x[e], 0x114, 0xf);
#pragma unroll
    for (int e = 0; e < N; ++e) x[e] += DPPF(x[e], 0x118, 0xf);
#pragma unroll
    for (int e = 0; e < N; ++e) x[e] += DPPF(x[e], 0x142, 0xa);
#pragma unroll
    for (int e = 0; e < N; ++e) x[e] += DPPF(x[e], 0x143, 0xc);
}
#define LBAR() do { asm volatile("s_waitcnt lgkmcnt(0)" ::: "memory"); __builtin_amdgcn_s_barrier(); asm volatile("" ::: "memory"); } while (0)

template <int MIX>
__device__ __forceinline__ void scan_chain(const Params& p, const int layer, const bool last, const int b, const int h, const int d, LAS unsigned char* lds) {
    const int tid = tid_opaque(), lane = tid & 63, w = tid >> 6, fr = lane & 15, fq = lane >> 4;
    const int gs = lane, c0 = w * 8;
    constexpr int NQ = MIX == 3 ? 4 : 8;
    const int cq0 = MIX == 3 ? w * 4 : w * 8;
    const int ds = tid >> 3, dc0 = (tid & 7) * 8;
    const bf16* P = (const bf16*)(p.ws + WS_P);
    bf16* Y = (bf16*)(p.ws + (d ? WS_H : WS_YF));
    LAS bf16* AT = (LAS bf16*)(lds + L_AT);
    LAS float* DEN = (LAS float*)(lds + L_DEN); LAS float* NST = (LAS float*)(lds + L_NST);
    LAS float* WA = (LAS float*)(lds + L_WA); LAS float* BA = (LAS float*)(lds + L_BA); LAS float* COLC = (LAS float*)(lds + L_COLC); LAS float* COLS = (LAS float*)(lds + L_COLS);
    LAS float* LBV = (LAS float*)(lds + L_LB); LAS float* ROWT = (LAS float*)(lds + L_ROWT);
    for (int i = tid; i < 64 * RS / 2; i += 512) ((LAS unsigned*)(lds + L_ST))[i] = 0u;
    if (tid < 64) NST[tid] = 0.f;
    float cA = 0.f, cB = 0.f;
    if (MIX == 0) { if (tid < 64) { const int ch = h * 64 + tid; const float l0 = p.lb_logits[(0 * 2 + d) * 256 + ch], l1 = p.lb_logits[(1 * 2 + d) * 256 + ch]; const float mx = fmaxf(l0, l1);
            const float e0 = __expf(l0 - mx), e1 = __expf(l1 - mx), sm0 = e0 / (e0 + e1), sm1 = e1 / (e0 + e1); LBV[tid] = layer == 0 ? 0.f : fmaxf((sm0 + sm1) - sm0, 0.f); } }
    if (MIX == 1) { cA = p.ml_bias[((layer * 2 + d) * 2 + 0) * 4 + h]; cB = p.ml_bias[((layer * 2 + d) * 2 + 1) * 4 + h]; }
    if (MIX == 2) { cA = logsigmoidf_(p.rt_logit[(layer * 2 + d) * 4 + h]);
        for (int i = tid; i < 1024; i += 512) { const int j = i >> 4, fi = i & 15; const float inv = exp2f(-(float)fi * (13.287712379549449f / 16.f)); float sn, cs; sincos_red((float)j, inv, sn, cs); COLC[fi * 64 + j] = cs; COLS[fi * 64 + j] = sn; } }
    if (MIX == 3) { for (int i = tid; i < 2 * L_BUF / 4; i += 512) ((LAS unsigned*)lds)[i] = 0u;
        __syncthreads();
        if (tid < 32) { ((LAS float*)(lds + L_DL))[32 + tid] = 1.f; ((LAS float*)(lds + L_BUF + L_DL))[32 + tid] = 1.f; }
        { const int r = tid >> 5, c = tid & 31; WA[tid] = p.gla_w[((size_t)(layer * 2 + d) * 16 + r) * 128 + h * 32 + c]; } if (tid < 32) BA[tid] = p.gla_b[(layer * 2 + d) * 128 + h * 32 + tid]; }
    __syncthreads();
    float lbv[8];
#pragma unroll
    for (int e = 0; e < 8; ++e) lbv[e] = MIX == 0 ? LBV[c0 + e] : 0.f;
    float invf[8];
#pragma unroll
    for (int e = 0; e < 8; ++e) invf[e] = MIX == 2 ? exp2f(-(float)((w & 1) * 8 + e) * (13.287712379549449f / 16.f)) : 0.f;

    f32x4 S0 = {0.f, 0.f, 0.f, 0.f}, S1 = {0.f, 0.f, 0.f, 0.f};
    const int vt = w & 3, tp = (w >> 2) * 2;
    const int ycol = MIX * 256 + h * 64;
    u32x4 ra = {0u, 0u, 0u, 0u}, rb = ra, rc = ra, rd = ra, re = ra;

#define SCAN_LOAD(ii) do { const int i_ = (ii); const bool ic_ = i_ < 4; const int ci_ = ic_ ? i_ : i_ - 4; const int nch_ = ic_ ? 4 : 128; const int cx_ = d ? nch_ - 1 - ci_ : ci_; \
        const int row_ = (ic_ ? MLAT + b * CTXL : b * SEQ) + cx_ * 64 + (d ? 63 - gs : gs); const bf16* rp_ = P + (size_t)row_ * INP; \
        if (MIX == 0) { ra = *(const u32x4*)(rp_ + C_HG_Q + h * 64 + c0); rb = *(const u32x4*)(rp_ + (d ? C_HG_FB : C_HG_FF) + h * 64 + c0); rc = *(const u32x4*)(rp_ + C_HG_I + h * 64 + c0); } \
        if (MIX == 1) { ra = *(const u32x4*)(rp_ + C_ML_Q + h * 64 + c0); rb = *(const u32x4*)(rp_ + C_ML_K + h * 64 + c0); rc = *(const u32x4*)(rp_ + C_ML_V + h * 64 + c0); rd = *(const u32x4*)(rp_ + C_ML_IF + d * 8); } \
        if (MIX == 2) { ra = *(const u32x4*)(rp_ + C_RT_Q + h * 64 + c0); rb = *(const u32x4*)(rp_ + C_RT_K + h * 64 + c0); rc = *(const u32x4*)(rp_ + C_RT_V + h * 64 + c0); \
                        rd = *(const u32x4*)(rp_ + C_RT_Q + h * 64 + (c0 ^ 16)); re = *(const u32x4*)(rp_ + C_RT_K + h * 64 + (c0 ^ 16)); } \
        if (MIX == 3) { { const u32x2 t_ = *(const u32x2*)(rp_ + C_GL_Q + h * 32 + cq0); ra.x = t_.x; ra.y = t_.y; } { const u32x2 t_ = *(const u32x2*)(rp_ + C_GL_K + h * 32 + cq0); rb.x = t_.x; rb.y = t_.y; } \
                        rd = *(const u32x4*)(rp_ + (d ? C_GL_AB : C_GL_AF)); re = *(const u32x4*)(rp_ + (d ? C_GL_AB : C_GL_AF) + 8); \
                        rc = *(const u32x4*)(rp_ + C_GL_V + h * 64 + c0); } \
    } while (0)

    SCAN_LOAD(0);
    for (int i = -1; i < 132; ++i) {
        const bool is_ctx = i < 4; const int ci = is_ctx ? i : i - 4; const int nch = is_ctx ? 4 : 128; const int cidx = d ? nch - 1 - ci : ci;
        const int base = (is_ctx ? MLAT + b * CTXL : b * SEQ) + cidx * 64;
        LAS unsigned char* bufc = lds + (i & 1) * L_BUF;
        LAS bf16* QM = (LAS bf16*)(bufc + L_QM); LAS bf16* QD = (LAS bf16*)(bufc + L_QD); LAS bf16* KM = (LAS bf16*)(bufc + L_KM); LAS bf16* KET = (LAS bf16*)(bufc + L_KET);
        LAS bf16* VT = (LAS bf16*)(bufc + L_VT); LAS float* DL = (LAS float*)(bufc + L_DL);
        LAS bf16* STc = (LAS bf16*)(lds + L_ST + (i & 1) * 9216); LAS bf16* STn = (LAS bf16*)(lds + L_ST + ((i + 1) & 1) * 9216);
        if (i >= 0) {
#pragma unroll
        for (int ti = 0; ti < 2; ++ti) { const int tt = tp + ti; f32x4 acc = {0.f, 0.f, 0.f, 0.f};
#pragma unroll
            for (int kk = 0; kk < 2; ++kk) { const bf16x8 a = *(const LAS bf16x8*)(KM + (vt * 16 + fr) * RS + kk * 32 + fq * 8); const bf16x8 bq = *(const LAS bf16x8*)(QM + (tt * 16 + fr) * RS + kk * 32 + fq * 8);
                acc = __builtin_amdgcn_mfma_f32_16x16x32_bf16(a, bq, acc, 0, 0, 0); }
            const int tg = tt * 16 + fr, s0 = vt * 16 + fq * 4;
            const float o0 = (s0 + 0 <= tg) ? acc[0] : 0.f, o1 = (s0 + 1 <= tg) ? acc[1] : 0.f, o2 = (s0 + 2 <= tg) ? acc[2] : 0.f, o3 = (s0 + 3 <= tg) ? acc[3] : 0.f;
            u32x2 wv; wv.x = pk_bf16(o0, o1); wv.y = pk_bf16(o2, o3); *(LAS u32x2*)(AT + tg * RS + s0) = wv; }
        }
        if (i + 1 < 132) {
            const int j = i + 1;
            const bool is_ctx = j < 4; const int ci = is_ctx ? j : j - 4; const int nch = is_ctx ? 4 : 128; const int cidx = d ? nch - 1 - ci : ci;
            LAS unsigned char* bufc = lds + (j & 1) * L_BUF;
            LAS bf16* QM = (LAS bf16*)(bufc + L_QM); LAS bf16* QD = (LAS bf16*)(bufc + L_QD); LAS bf16* KM = (LAS bf16*)(bufc + L_KM); LAS bf16* KET = (LAS bf16*)(bufc + L_KET);
            LAS bf16* VT = (LAS bf16*)(bufc + L_VT); LAS float* DL = (LAS float*)(bufc + L_DL);
            (void)cidx; (void)QD; (void)KM;
        float q[8], k[8], v[8], la[8];
        unpack8(ra, q); unpack8(rb, k); unpack8(rc, v);
        const u32x4 rd0 = rd, re0 = re;
        if (j + 1 < 132) SCAN_LOAD(j + 1);
        if (MIX == 0) {
#pragma unroll
            for (int e = 0; e < 8; ++e) { const float z = k[e], qr = q[e]; q[e] = qr * __builtin_amdgcn_rcpf(1.f + __expf(-qr));
                const float ez = __expf(-fabsf(z)), i1 = __builtin_amdgcn_rcpf(1.f + ez), ei = ez * i1; const float sp = z >= 0.f ? i1 : ei, sn = z >= 0.f ? ei : i1;
                const float om = 1.f - lbv[e], f = lbv[e] + om * sp;
                la[e] = __logf(fmaxf(f, 1e-37f)); k[e] = om * sn; }
        }
        if (MIX == 1) {
            float g8[8]; unpack8(rd0, g8);
            const float pi = (h == 0 ? g8[0] : h == 1 ? g8[1] : h == 2 ? g8[2] : g8[3]) + cA, pf = (h == 0 ? g8[4] : h == 1 ? g8[5] : h == 2 ? g8[6] : g8[7]) + cB;
            const float lf = logsigmoidf_(pf), ei = 0.125f * __expf(pi);
#pragma unroll
            for (int e = 0; e < 8; ++e) { k[e] *= ei; la[e] = lf; }
        }
        if (MIX == 2) {
#pragma unroll
            for (int e = 0; e < 8; ++e) { k[e] *= 0.125f; la[e] = cA; }
            if (tid < 16 && j + 1 >= 4 && j + 1 < 132) {
                const int cn = d ? 127 - (j + 1 - 4) : (j + 1 - 4); float sn_, cs_; sincos_red((float)cn, exp2f(-(float)tid * (13.287712379549449f / 16.f)), sn_, cs_);
                ROWT[((j + 1) & 1) * 32 + tid] = cs_; ROWT[((j + 1) & 1) * 32 + 16 + tid] = sn_; }
            if (!is_ctx) {
                const int colpos = d ? 63 - gs : gs;
                float qp[8], kp[8]; unpack8(rd0, qp); unpack8(re0, kp);
#pragma unroll
                for (int e = 0; e < 8; ++e) {
                    float sn, cs;
                    if (w < 4) { cs = ROWT[(j & 1) * 32 + (w & 1) * 8 + e]; sn = ROWT[(j & 1) * 32 + 16 + (w & 1) * 8 + e]; } else { sn = COLS[((w & 1) * 8 + e) * 64 + colpos]; cs = COLC[((w & 1) * 8 + e) * 64 + colpos]; }
                    const float kpe = kp[e] * 0.125f;
                    if ((w & 2) == 0) { q[e] = q[e] * cs - qp[e] * sn; k[e] = k[e] * cs - kpe * sn; } else { q[e] = qp[e] * sn + q[e] * cs; k[e] = kpe * sn + k[e] * cs; }
                }
            }
        }
        if (MIX == 3) {
            float z0[8], z1[8]; unpack8(rd0, z0); unpack8(re0, z1);
            float za[4];
#pragma unroll
            for (int e = 0; e < 4; ++e) za[e] = BA[cq0 + e];
#pragma unroll
            for (int r = 0; r < 8; ++r) {
#pragma unroll
                for (int e = 0; e < 4; ++e) za[e] += z0[r] * WA[r * 32 + cq0 + e] + z1[r] * WA[(r + 8) * 32 + cq0 + e]; }
#pragma unroll
            for (int e = 0; e < 4; ++e) { la[e] = logsigmoidf_(za[e]) * (1.f / 16.f); k[e] *= 0.17677669529663687f; }
#pragma unroll
            for (int e = 4; e < 8; ++e) { la[e] = 0.f; q[e] = 0.f; k[e] = 0.f; }
        }
        wave_incl_scanN<NQ>(la);
        {
            float qm[8], qd[8], km[8], dlv[8];
#pragma unroll
            for (int e = 0; e < 8; ++e) { qm[e] = 0.f; qd[e] = 0.f; km[e] = 0.f; dlv[e] = 1.f; }
#pragma unroll
            for (int e = 0; e < NQ; ++e) { const float bb = la[e], bm = rdlane(bb, 31), bl = rdlane(bb, 63);
                const float E1 = __expf(fminf(fmaxf(bb - bm, -80.f), 80.f)), R1 = __builtin_amdgcn_rcpf(E1), Em = __expf(bm), Elm = __expf(bl - bm);
                qm[e] = q[e] * E1; qd[e] = qm[e] * Em; km[e] = k[e] * R1;
                KET[(cq0 + e) * RS + gs] = bf1(km[e] * Elm);
                dlv[e] = Em * Elm; }
#pragma unroll
            for (int e = 0; e < 8; ++e) VT[(c0 + e) * RS + gs] = bf1(v[e]);
            if (MIX == 3) {
                if (lane == 63) *(LAS f32x4*)(DL + cq0) = (f32x4){dlv[0], dlv[1], dlv[2], dlv[3]};
                const u32x4 pq = pack8(qm), pd = pack8(qd), pk = pack8(km);
                *(LAS u32x2*)(QM + gs * RS + cq0) = (u32x2){pq.x, pq.y}; *(LAS u32x2*)(QD + gs * RS + cq0) = (u32x2){pd.x, pd.y}; *(LAS u32x2*)(KM + gs * RS + cq0) = (u32x2){pk.x, pk.y};
            } else {
                if (lane == 63) { *(LAS f32x4*)(DL + c0) = (f32x4){dlv[0], dlv[1], dlv[2], dlv[3]}; *(LAS f32x4*)(DL + c0 + 4) = (f32x4){dlv[4], dlv[5], dlv[6], dlv[7]}; }
                *(LAS u32x4*)(QM + gs * RS + c0) = pack8(qm); *(LAS u32x4*)(QD + gs * RS + c0) = pack8(qd); *(LAS u32x4*)(KM + gs * RS + c0) = pack8(km);
            }
        }
        }
        LBAR();
        if (i >= 0) {
        bf16x8 av[2], as_[2];
#pragma unroll
        for (int kk = 0; kk < 2; ++kk) { av[kk] = *(const LAS bf16x8*)(VT + (vt * 16 + fr) * RS + kk * 32 + fq * 8); as_[kk] = *(const LAS bf16x8*)(STc + (vt * 16 + fr) * RS + kk * 32 + fq * 8); }
        f32x4 o[2], U[2];
#pragma unroll
        for (int ti = 0; ti < 2; ++ti) { const int tt = tp + ti; f32x4 acc = {0.f, 0.f, 0.f, 0.f};
#pragma unroll
            for (int kk = 0; kk < 2; ++kk) { const bf16x8 b1 = *(const LAS bf16x8*)(AT + (tt * 16 + fr) * RS + kk * 32 + fq * 8); acc = __builtin_amdgcn_mfma_f32_16x16x32_bf16(av[kk], b1, acc, 0, 0, 0);
                const bf16x8 b2 = *(const LAS bf16x8*)(QD + (tt * 16 + fr) * RS + kk * 32 + fq * 8); acc = __builtin_amdgcn_mfma_f32_16x16x32_bf16(as_[kk], b2, acc, 0, 0, 0); }
            o[ti] = acc; }
#pragma unroll
        for (int ci2 = 0; ci2 < 2; ++ci2) { const int ct = tp + ci2; f32x4 acc = {0.f, 0.f, 0.f, 0.f};
#pragma unroll
            for (int kk = 0; kk < 2; ++kk) { const bf16x8 b1 = *(const LAS bf16x8*)(KET + (ct * 16 + fr) * RS + kk * 32 + fq * 8); acc = __builtin_amdgcn_mfma_f32_16x16x32_bf16(av[kk], b1, acc, 0, 0, 0); }
            U[ci2] = acc; }
        if (MIX == 1) {
            float a8[8], q8[8]; unpack8(*(const LAS u32x4*)(AT + ds * RS + dc0), a8); unpack8(*(const LAS u32x4*)(QD + ds * RS + dc0), q8);
            const f32x4 n0 = *(const LAS f32x4*)(NST + dc0), n1 = *(const LAS f32x4*)(NST + dc0 + 4);
            float dsum = (a8[0] + a8[1]) + (a8[2] + a8[3]) + (a8[4] + a8[5]) + (a8[6] + a8[7]);
            dsum += q8[0] * n0.x + q8[1] * n0.y + q8[2] * n0.z + q8[3] * n0.w + q8[4] * n1.x + q8[5] * n1.y + q8[6] * n1.z + q8[7] * n1.w;
            dsum += __shfl_xor(dsum, 1); dsum += __shfl_xor(dsum, 2); dsum += __shfl_xor(dsum, 4);
            if ((tid & 7) == 0) DEN[ds] = dsum;
            LBAR();
#pragma unroll
            for (int ti = 0; ti < 2; ++ti) { const float dd = DEN[(tp + ti) * 16 + fr]; o[ti] = o[ti] * (1.f / fmaxf(fabsf(dd), 1.f)); }
        }
        if (!(is_ctx && last)) {
#pragma unroll
            for (int ti = 0; ti < 2; ++ti) { const int t = (tp + ti) * 16 + fr; const int grow = base + (d ? 63 - t : t);
                u32x2 wv; wv.x = pk_bf16(o[ti][0], o[ti][1]); wv.y = pk_bf16(o[ti][2], o[ti][3]); *(u32x2*)(Y + (size_t)grow * DM + ycol + vt * 16 + fq * 4) = wv; }
        }
        { const float dl0 = DL[tp * 16 + fr], dl1 = DL[(tp + 1) * 16 + fr]; S0 = S0 * dl0 + U[0]; S1 = S1 * dl1 + U[1]; }
#pragma unroll
        for (int j = 0; j < 4; ++j) { STn[(vt * 16 + fq * 4 + j) * RS + tp * 16 + fr] = bf1(S0[j]); STn[(vt * 16 + fq * 4 + j) * RS + (tp + 1) * 16 + fr] = bf1(S1[j]); }
        if (MIX == 1) {
            float k8[8]; unpack8(*(const LAS u32x4*)(KET + ds * RS + dc0), k8);
            float ks = (k8[0] + k8[1]) + (k8[2] + k8[3]) + (k8[4] + k8[5]) + (k8[6] + k8[7]);
            ks += __shfl_xor(ks, 1); ks += __shfl_xor(ks, 2); ks += __shfl_xor(ks, 4);
            if ((tid & 7) == 0) NST[ds] = DL[ds] * NST[ds] + ks;
        }
        }
        LBAR();
    }
#undef SCAN_LOAD
    __syncthreads();
}
__device__ __forceinline__ void scan_phase(const Params& p, const int layer, const bool last, LAS unsigned char* lds) {
    for (int id = blockIdx.x; id < 256; id += gridDim.x) {
        const int d = id & 1, h = (id >> 1) & 3, mix = (id >> 3) & 3, b = id >> 5;
        __syncthreads();
        if (mix == 0) scan_chain<0>(p, layer, last, b, h, d, lds);
        else if (mix == 1) scan_chain<1>(p, layer, last, b, h, d, lds);
        else if (mix == 2) scan_chain<2>(p, layer, last, b, h, d, lds);
        else scan_chain<3>(p, layer, last, b, h, d, lds);
    }
}

#define XB_TMO      128
#define XB_XCNT(j)  (256  + 64 * (j))
#define XB_XSUB(j)  (1280 + 64 * (j))
#define XB_XGEN(j)  (2304 + 64 * (j))
#define XB_TOP      3328
#define XB_TOPGEN   3392
#define XCD_BAR_WORDS 3456
#define XB_SPIN_CAP (1u << 18)

__device__ __forceinline__ unsigned xb_ld(unsigned* p)              { return __hip_atomic_load(p, __ATOMIC_RELAXED, __HIP_MEMORY_SCOPE_AGENT); }
__device__ __forceinline__ unsigned xb_add(unsigned* p, unsigned v) { return __hip_atomic_fetch_add(p, v, __ATOMIC_RELAXED, __HIP_MEMORY_SCOPE_AGENT); }
__device__ __forceinline__ unsigned xb_xcc_id() { return (unsigned)__builtin_amdgcn_s_getreg((3 << 11) | 20) & 0xFu; }
#define XB_SPIN(cond, bar) do { unsigned _sp = 0; while (cond) { __builtin_amdgcn_s_sleep(1); \
    if ((++_sp & 255u) == 0u) { if (xb_ld(&(bar)[XB_TMO])) break; if (_sp > XB_SPIN_CAP) { atomicAdd(&(bar)[XB_TMO], 1u); break; } } } } while (0)

struct XcdBarrier {
    unsigned* bar; unsigned x;
    volatile LAS unsigned* st;
};

__device__ __forceinline__ XcdBarrier xcd_barrier_post(unsigned* bar, volatile LAS unsigned* st) {
    XcdBarrier b; b.bar = bar; b.x = xb_xcc_id(); b.st = st;
    if (threadIdx.x == 0) (void)xb_add(&bar[XB_XCNT(b.x)], 1u);
    return b;
}
__device__ __forceinline__ void xcd_barrier_complete(unsigned* bar, unsigned x, unsigned& nloc, unsigned& nx) {
    const unsigned G = gridDim.x * gridDim.y * gridDim.z;
    unsigned sum, cnt, mine, sp = 0u;
    for (;;) {
        sum = 0u; cnt = 0u; mine = 0u;
#pragma unroll
        for (unsigned j = 0; j < 16; ++j) { const unsigned c = xb_ld(&bar[XB_XCNT(j)]); sum += c; cnt += (c > 0u) ? 1u : 0u; mine = (j == x) ? c : mine; }
        if (sum == G) break;
        __builtin_amdgcn_s_sleep(1);
        if ((++sp & 255u) == 0u) { if (xb_ld(&bar[XB_TMO])) break; if (sp > XB_SPIN_CAP) { atomicAdd(&bar[XB_TMO], 1u); break; } }
    }
    nloc = mine > 0u ? mine : 1u; nx = cnt > 0u ? cnt : 1u;
}

__device__ __forceinline__ void xcd_barrier(const XcdBarrier& b) {
    asm volatile("s_waitcnt vmcnt(0)" ::: "memory");
    __syncthreads();
    if (threadIdx.x == 0) {
        unsigned* bar = b.bar;
        __builtin_amdgcn_s_waitcnt(0);
        unsigned nloc = b.st[0], nx = b.st[1];
        if (nloc == 0u) { xcd_barrier_complete(bar, b.x, nloc, nx); b.st[0] = nloc; b.st[1] = nx; }
        const unsigned old = xb_add(&bar[XB_XSUB(b.x)], 1u);
        const unsigned gen = old / nloc;
        if (old + 1u == (gen + 1u) * nloc) {
            __builtin_amdgcn_fence(__ATOMIC_RELEASE, "agent");
            asm volatile("s_waitcnt vmcnt(0)" ::: "memory");
            const unsigned og = xb_add(&bar[XB_TOP], 1u);
            const unsigned tg = og / nx;
            if (og + 1u == (tg + 1u) * nx) xb_add(&bar[XB_TOPGEN], 1u);
            else XB_SPIN(xb_ld(&bar[XB_TOPGEN]) == tg, bar);
            __builtin_amdgcn_fence(__ATOMIC_ACQUIRE, "agent");
            xb_add(&bar[XB_XGEN(b.x)], 1u);
            asm volatile("s_waitcnt vmcnt(0)" ::: "memory");
        } else {
            XB_SPIN(xb_ld(&bar[XB_XGEN(b.x)]) == gen, bar);
            __builtin_amdgcn_fence(__ATOMIC_ACQUIRE, "agent");
            asm volatile("s_waitcnt vmcnt(0)" ::: "memory");
        }
    }
    __syncthreads();
}

__global__ void __launch_bounds__(512, 2) mega(Params p) {
    extern __shared__ __attribute__((aligned(16))) unsigned char lds_raw[];
    LAS unsigned char* lds = (LAS unsigned char*)lds_raw;
    cgrp::grid_group grid = cgrp::this_grid();
    const int lo = p.ph_lo, hi = p.ph_hi;
#define IN(k) (lo <= (k) && (k) < hi)
    constexpr int L_XB = LDS_BYTES - 128;
    if (threadIdx.x < 2) ((LAS unsigned*)(lds + L_XB))[threadIdx.x] = 0u;
    __syncthreads();
    XcdBarrier xbar = xcd_barrier_post((unsigned*)p.ws, (volatile LAS unsigned*)(lds + L_XB));
#define SYNC(k) do { if (lo <= (k) && (k) + 1 < hi) { if ((k) == 0) grid.sync(); else xcd_barrier(xbar); } } while (0)
    unsigned char* ws = p.ws;
    float* mod = (float*)(ws + WS_MOD); float* xc = (float*)(ws + WS_XC);
    bf16* H = (bf16*)(ws + WS_H); bf16* YF = (bf16*)(ws + WS_YF); bf16* PB = (bf16*)(ws + WS_P);

    float* ss1 = (float*)(ws + WS_SS1); float* ss2 = (float*)(ws + WS_SS2); const float* biasb = (const float*)(ws + WS_BIAS);
    if (IN(0)) { prologue_phase(p, lds); } SYNC(0);
    if (IN(1)) { init_scale_phase(p.x, p.ctx, mod, DM, H, ss2); bias_gemv_phase(p, lds, 0, 0); } SYNC(1);
    for (int l = 0; l < 2; ++l) {
        const int pb = 2 + 6 * l; const bool last = l == 1; const int Mrows = last ? MLAT : MALL;
        const float* modl = mod + (size_t)l * 9 * MODW;
        if (IN(pb + 0)) { pg8::Gemm g{H, (const bf16*)(ws + WS_WIN + l * WIN_BYTES), MALL, INP, DM}; pg8::StaticOrder S; S.init(MALL, INP, (int)gridDim.x, (int)blockIdx.x);
            EpiNormAct<0, INP> E{PB, ss2, biasb + (size_t)(l * 2 + 0) * 9 * INP};
            pg8::gemm_phase<EpiNormAct<0, INP>, pg8::StaticOrder, true, true>(lds, g, S, E); }
        SYNC(pb + 0);
        if (IN(pb + 1)) { scan_phase(p, l, last, lds); }
        SYNC(pb + 1);
        if (IN(pb + 2)) { gate_phase(p, l, Mrows); }
        SYNC(pb + 2);
        if (IN(pb + 3)) { pg8::Gemm g{YF, (const bf16*)(ws + WS_WOUT + l * 2 * MiB), Mrows, DM, DM}; pg8::StaticOrder S; S.init(Mrows, DM, (int)gridDim.x, (int)blockIdx.x);
            EpiResNorm E{l == 0 ? p.x : p.out, l == 0 ? p.ctx : xc, p.out, xc, modl + 2 * DM, modl + 4 * DM, H, ss1, 1};
            pg8::gemm_phase<EpiResNorm, pg8::StaticOrder, true, true>(lds, g, S, E);
            if (!last) mod_gemv_phase(p, lds, 1, 32); }
        SYNC(pb + 3);
        if (IN(pb + 4)) { pg8::Gemm g{H, (const bf16*)(ws + WS_WFF1 + l * 8 * MiB), Mrows, DFF, DM}; pg8::StaticOrder S; S.init(Mrows, DFF, (int)gridDim.x, (int)blockIdx.x);
            EpiNormAct<1, DFF> E{PB, ss1, biasb + (size_t)(l * 2 + 1) * 9 * INP};
            pg8::gemm_phase<EpiNormAct<1, DFF>, pg8::StaticOrder, true, true>(lds, g, S, E); }
        SYNC(pb + 4);
        if (IN(pb + 5)) { pg8::Gemm g{PB, (const bf16*)(ws + WS_WFF2 + l * 8 * MiB), Mrows, DM, DFF}; pg8::StaticOrder S; S.init(Mrows, DM, (int)gridDim.x, (int)blockIdx.x);
            EpiResNorm E{p.out, xc, p.out, xc, modl + 5 * DM, last ? (const float*)nullptr : mod + (size_t)9 * MODW + DM, H, ss2, last ? 0 : 1};
            pg8::gemm_phase<EpiResNorm, pg8::StaticOrder, true, true>(lds, g, S, E);
            if (!last) { prep_layer1_weights(p, lds, 32); bias_gemv_phase(p, lds, 1, 32); } }
        SYNC(pb + 5);
    }
    if (IN(14)) { final_norm_phase(p.out, H, p.g_final, ss2); }
#undef IN
#undef SYNC
}

extern "C" void kernel_launch(void* const* d_in, const int* in_sizes, int n_in, void* d_out, int out_size, void* d_ws, size_t ws_size, hipStream_t stream) {
    static int grid = 0;
    if (grid == 0) {
        int dev = 0, cus = 0, per_cu = 0;
        (void)hipGetDevice(&dev); (void)hipDeviceGetAttribute(&cus, hipDeviceAttributeMultiprocessorCount, dev);
        if (hipFuncSetAttribute((const void*)mega, hipFuncAttributeMaxDynamicSharedMemorySize, LDS_BYTES) != hipSuccess) fprintf(stderr, "kernel_launch: hipFuncSetAttribute failed\n");
        if (hipOccupancyMaxActiveBlocksPerMultiprocessor(&per_cu, (const void*)mega, 512, LDS_BYTES) != hipSuccess || per_cu < 1) { fprintf(stderr, "kernel_launch: occupancy query says %d\n", per_cu); per_cu = 1; }
        (void)hipGetLastError();
        grid = cus * per_cu; if (grid <= 0) grid = 256;
    }
    Params p{};
    p.x = (const float*)d_in[0]; p.c = (const float*)d_in[1]; p.ctx = (const float*)d_in[2]; p.c_ctx = (const float*)d_in[3]; p.w_ada = (const float*)d_in[4]; p.b_ada = (const float*)d_in[5];
    p.w_in = (const float*)d_in[6]; p.g_heads = (const float*)d_in[7]; p.lb_logits = (const float*)d_in[8]; p.ml_bias = (const float*)d_in[9]; p.rt_logit = (const float*)d_in[10];
    p.gla_w = (const float*)d_in[11]; p.gla_b = (const float*)d_in[12]; p.w_out = (const float*)d_in[13]; p.w_ff1 = (const float*)d_in[14]; p.w_ff2 = (const float*)d_in[15]; p.g_final = (const float*)d_in[16];
    p.out = (float*)d_out; p.ws = (unsigned char*)d_ws;
#if MK_MULTI
    for (int k = 0; k < NPHASE; ++k) { p.ph_lo = k; p.ph_hi = k + 1; hipLaunchKernelGGL(mega, dim3(grid), dim3(512), LDS_BYTES, stream, p); }
#else
    p.ph_lo = 0; p.ph_hi = NPHASE;
    if (hipMemsetAsync(d_ws, 0, 16384, stream) != hipSuccess) fprintf(stderr, "kernel_launch: memset of the barrier words failed\n");
    void* args[] = {&p};
    hipError_t e = hipLaunchCooperativeKernel((const void*)mega, dim3(grid), dim3(512), args, LDS_BYTES, stream);
    if (e != hipSuccess) fprintf(stderr, "cooperative launch failed: %s (grid %d)\n", hipGetErrorString(e), grid);
#endif
}
```

```cpp
#include <hip/hip_runtime.h>
#include <hip/hip_cooperative_groups.h>
#include <cstdio>
#include <cstdint>
namespace cgrp = cooperative_groups;
namespace pg8 {
#define PG8_LAS __attribute__((address_space(3)))
typedef unsigned short bf16_t;
typedef short bf16x8 __attribute__((ext_vector_type(8)));
typedef float f32x4 __attribute__((ext_vector_type(4)));
typedef unsigned u32x4 __attribute__((ext_vector_type(4)));
constexpr int BM = 256, BK = 64, HALF = 128, HTB = HALF * BK * 2  , STAGE_BYTES = 8 * HTB, NXCD = 8, WGM = 8;

__host__ __device__ __forceinline__ int lds_byte(int r, int c) { const int st = (r >> 4) * 2 + (c >> 5), rr = r & 15, cc = c & 31, ob = rr * 64 + cc * 2; return st * 1024 + (ob ^ (((ob >> 9) & 1) << 5)); }
__host__ __device__ __forceinline__ void stage_rc(int b, int& R, int& C) { const int st = b / 1024, sb = b % 1024, swz = sb ^ (((sb >> 9) & 1) << 5); R = (st >> 1) * 16 + swz / 64; C = (st & 1) * 32 + (swz % 64) / 2; }
__host__ __device__ __forceinline__ int perm32(int rho) { const int n = rho >> 4, i = rho & 15; return 8 * (i >> 2) + 4 * n + (i & 3); }

struct Unit { int pm, pn; };
struct Gemm { const bf16_t* A; const bf16_t* Bt; int M, N, K; };

struct StaticOrder {
    int nM, nN, nwg, G, c;
    __host__ __device__ void init(int M, int N, int G_, int c_) { nM = M / BM; nN = N / BM; nwg = nM * nN; G = G_; c = c_; }
    __host__ __device__ bool next(int i, Unit& u) const {
        const long L = (long)i * G + c; if (L >= nwg) return false;
        int wgid = (int)L; { const int q = nwg / NXCD, r = nwg % NXCD, xcd = wgid % NXCD, off = wgid / NXCD; wgid = (xcd < r ? xcd * (q + 1) : r * (q + 1) + (xcd - r) * q) + off; }
        const int nig = WGM * nN, gid = wgid / nig, fm = gid * WGM, gsz = (nM - fm) < WGM ? (nM - fm) : WGM;
        u.pm = fm + ((wgid % nig) % gsz); u.pn = (wgid % nig) / gsz; return true;
    }
    __device__ __forceinline__ void a_ready(const Unit&) const {}
    __device__ __forceinline__ void done(const Unit&) const {}
};

__device__ __forceinline__ unsigned cvt_pk_bf16(float lo, float hi) { unsigned r; asm volatile("v_cvt_pk_bf16_f32 %0, %1, %2" : "=v"(r) : "v"(lo), "v"(hi)); return r; }
typedef float f32x2 __attribute__((ext_vector_type(2)));
__device__ __forceinline__ f32x2 gelu_pk(f32x2 v) {
    const f32x2 av = __builtin_elementwise_abs(v), d = av * 0.2316418882f + 1.0f;
    f32x2 t; t.x = __builtin_amdgcn_rcpf(d.x); t.y = __builtin_amdgcn_rcpf(d.y);
    f32x2 q = t * 0.5307027145f + (-0.7265760135f); q = q * t + 0.7107068705f; q = q * t + (-0.142248368f); q = q * t + 0.127414796f; q = q * t;
    const f32x2 s = (v * v) * (-0.72134752044f);
    f32x2 e; e.x = __builtin_amdgcn_exp2f(s.x); e.y = __builtin_amdgcn_exp2f(s.y);
    const f32x2 m = v * (q * e), r = v - m;
    f32x2 o; o.x = v.x < 0.f ? m.x : r.x; o.y = v.y < 0.f ? m.y : r.y; return o;
}

template <int ACT  > struct EpiBf16 {
    static constexpr bool PERM = true, AFTER_DRAIN = false; static_assert(ACT == 0 || ACT == 1, "EpiBf16: ACT is 0 (none) or 1 (gelu_pk)");
    bf16_t* O; int ldc; const float* bias; int split_cols; size_t split_stride; float scale0;
    __device__ __forceinline__ void operator()(const f32x4 (&acc)[2][2][4][2], const Unit& u, int wr, int wc, int fr, int fq) const {
        const int row0 = u.pm * BM + wr * 64 + fr; int colt = u.pn * BM; bf16_t* base = O;
        float sc = 1.f; if (split_cols) { const int t = colt / split_cols; base += (size_t)t * split_stride; colt -= t * split_cols; if (t == 0) sc = scale0; }
        const int col0 = colt + wc * 32 + 8 * fq, bcol0 = u.pn * BM + wc * 32 + 8 * fq;
        f32x4 bv[2][2];
#pragma unroll
        for (int bj = 0; bj < 2; ++bj)
#pragma unroll
            for (int n = 0; n < 2; ++n) bv[bj][n] = bias ? *(const f32x4*)(bias + bcol0 + bj * HALF + 4 * n) : (f32x4){0.f, 0.f, 0.f, 0.f};
#pragma unroll
        for (int ai = 0; ai < 2; ++ai)
#pragma unroll
            for (int m = 0; m < 4; ++m) { bf16_t* rowp = base + (size_t)(row0 + ai * HALF + m * 16) * ldc + col0;
#pragma unroll
                for (int bj = 0; bj < 2; ++bj) { f32x4 v0 = acc[ai][bj][m][0] + bv[bj][0], v1 = acc[ai][bj][m][1] + bv[bj][1];
                    if (ACT == 1) { f32x2 a = gelu_pk((f32x2){v0[0], v0[1]}), b = gelu_pk((f32x2){v0[2], v0[3]}), c = gelu_pk((f32x2){v1[0], v1[1]}), d = gelu_pk((f32x2){v1[2], v1[3]});
                        v0 = (f32x4){a.x, a.y, b.x, b.y}; v1 = (f32x4){c.x, c.y, d.x, d.y}; }
                    v0 = v0 * sc; v1 = v1 * sc; u32x4 w; w.x = cvt_pk_bf16(v0[0], v0[1]); w.y = cvt_pk_bf16(v0[2], v0[3]); w.z = cvt_pk_bf16(v1[0], v1[1]); w.w = cvt_pk_bf16(v1[2], v1[3]);
                    *(u32x4*)(rowp + bj * HALF) = w; } }
    }
};
template <class Epi, class Sched, bool ALIGN_EPI = false, bool SP2 = false>
__device__ __forceinline__ void gemm_phase(PG8_LAS unsigned char* lds, const Gemm g, const Sched& S, const Epi& E) {
    int tid_ = threadIdx.x; asm volatile("" : "+v"(tid_)); const int tid = tid_, wid = __builtin_amdgcn_readfirstlane(tid >> 6), lane = tid & 63, wr = wid >> 2, wc = wid & 3, fr = lane & 15, fq = lane >> 4;
    const int K = g.K, nt = K / BK;
    unsigned voffA[2], voffB[2];
#pragma unroll
    for (int i = 0; i < 2; ++i) { int R, C; stage_rc(tid * 16 + i * 8192, R, C); const int Rb = Epi::PERM ? ((R & ~31) + perm32(R & 31)) : R;
        voffA[i] = (unsigned)(R * K + C) * 2u; voffB[i] = (unsigned)(Rb * K + C) * 2u; }
    const size_t kstep = (size_t)(BK * 2);
    const size_t hstep = (size_t)HALF * K * 2;
    const size_t tstep = 2 * hstep;
    const unsigned ldsw = (unsigned)wid * 1024u;
    const int aoff = lds_byte(wr * 64 + fr, fq * 8), boff = lds_byte(wc * 32 + fr, fq * 8);
#define PG8_SA(b, h) (((b) * 2 + (h)) * HTB)
#define PG8_SB(b, h) ((4 + (b) * 2 + (h)) * HTB)
#define PG8_STAGE(bufoff, gbase, voff) do { _Pragma("unroll") for (int _i = 0; _i < 2; ++_i) \
        __builtin_amdgcn_global_load_lds((const unsigned*)((const char*)(gbase) + (voff)[_i]), (PG8_LAS unsigned*)(lds + (bufoff) + ldsw + _i * 8192), 16, 0, 0); } while (0)
#define PG8_LDA(dst, b, h) do { _Pragma("unroll") for (int m = 0; m < 4; ++m) _Pragma("unroll") for (int k = 0; k < 2; ++k) dst[m][k] = *(const PG8_LAS bf16x8*)(lds + PG8_SA(b, h) + aoff + m * 2048 + k * 1024); } while (0)
#define PG8_LDB(dst, b, h) do { _Pragma("unroll") for (int n = 0; n < 2; ++n) _Pragma("unroll") for (int k = 0; k < 2; ++k) dst[n][k] = *(const PG8_LAS bf16x8*)(lds + PG8_SB(b, h) + boff + n * 2048 + k * 1024); } while (0)
#define PG8_MMA(ai, bj, At, Bt) do { __builtin_amdgcn_s_setprio(1); _Pragma("unroll") for (int m = 0; m < 4; ++m) _Pragma("unroll") for (int n = 0; n < 2; ++n) _Pragma("unroll") for (int k = 0; k < 2; ++k) \
        acc[ai][bj][m][n] = __builtin_amdgcn_mfma_f32_16x16x32_bf16(Bt[n][k], At[m][k], acc[ai][bj][m][n], 0, 0, 0); __builtin_amdgcn_s_setprio(0); } while (0)
#define PG8_WAIT_V(n) asm volatile("s_waitcnt vmcnt(" #n ")" ::: "memory")
#define PG8_WAIT_L(n) asm volatile("s_waitcnt lgkmcnt(" #n ")" ::: "memory")
#define PG8_BAR __builtin_amdgcn_s_barrier()
#define PG8_SCHED __builtin_amdgcn_sched_barrier(0)
    Unit cur, nxt; int ui = 0;
    if (!S.next(0, cur)) return;
    f32x4 acc[2][2][4][2];
#pragma unroll
    for (int a = 0; a < 2; ++a)
#pragma unroll
        for (int b = 0; b < 2; ++b)
#pragma unroll
            for (int m = 0; m < 4; ++m)
#pragma unroll
                for (int n = 0; n < 2; ++n) acc[a][b][m][n] = (f32x4){0.f, 0.f, 0.f, 0.f};
    bf16x8 At[4][2], B0[2][2], B1[2][2];
    const char* cA = (const char*)g.A + (size_t)cur.pm * tstep; const char* cB = (const char*)g.Bt + (size_t)cur.pn * tstep;
    S.a_ready(cur);
    if constexpr (SP2) {
        PG8_STAGE(PG8_SB(0, 0), cB, voffB); PG8_STAGE(PG8_SB(0, 1), cB + hstep, voffB); PG8_STAGE(PG8_SA(0, 0), cA, voffA); PG8_STAGE(PG8_SA(0, 1), cA + hstep, voffA);
        if (wr == 1) PG8_BAR;
        PG8_WAIT_V(2); PG8_BAR;
        PG8_STAGE(PG8_SB(1, 0), cB + kstep, voffB); PG8_STAGE(PG8_SA(1, 0), cA + kstep, voffA); PG8_STAGE(PG8_SB(1, 1), cB + hstep + kstep, voffB);
        PG8_WAIT_V(6); PG8_BAR;
    } else {
        PG8_STAGE(PG8_SB(0, 0), cB, voffB); PG8_STAGE(PG8_SA(0, 0), cA, voffA); PG8_STAGE(PG8_SB(0, 1), cB + hstep, voffB); PG8_STAGE(PG8_SA(0, 1), cA + hstep, voffA);
        if (wr == 1) PG8_BAR;
        PG8_WAIT_V(4); PG8_BAR;
        PG8_STAGE(PG8_SB(1, 0), cB + kstep, voffB); PG8_STAGE(PG8_SA(1, 0), cA + kstep, voffA); PG8_STAGE(PG8_SB(1, 1), cB + hstep + kstep, voffB);
        PG8_WAIT_V(6); PG8_BAR;
    }
    for (;;) {
        const bool has_next = S.next(ui + 1, nxt);
        const char* nA = has_next ? (const char*)g.A + (size_t)nxt.pm * tstep : cA; const char* nB = has_next ? (const char*)g.Bt + (size_t)nxt.pn * tstep : cB;
        for (int t = 0; t < nt; t += 2) {
            const bool last = (t == nt - 2);
            const char* a1 = cA + (size_t)(t + 1) * kstep;
            const char* a2 = last ? nA : cA + (size_t)(t + 2) * kstep; const char* b2 = last ? nB : cB + (size_t)(t + 2) * kstep;
            const char* a3 = a2 + kstep; const char* b3 = b2 + kstep;
            if (last && has_next) S.a_ready(nxt);
            if (last) E.prefetch(cur, wr, wc, fr, fq);
            if constexpr (SP2) {
            PG8_LDB(B0, 0, 0); PG8_LDB(B1, 0, 1); PG8_SCHED; PG8_LDA(At, 0, 0); PG8_STAGE(PG8_SA(1, 1), a1 + hstep, voffA);
            PG8_WAIT_V(8); PG8_WAIT_L(0); PG8_BAR; PG8_MMA(0, 0, At, B0); PG8_MMA(0, 1, At, B1); PG8_BAR; PG8_SCHED;
            PG8_LDA(At, 0, 1); PG8_STAGE(PG8_SB(0, 0), b2, voffB); PG8_STAGE(PG8_SB(0, 1), b2 + hstep, voffB); PG8_STAGE(PG8_SA(0, 0), a2, voffA);
            PG8_WAIT_V(8); PG8_WAIT_L(0); PG8_BAR; PG8_MMA(1, 0, At, B0); PG8_MMA(1, 1, At, B1); PG8_BAR; PG8_SCHED;
            PG8_LDB(B0, 1, 0); PG8_LDB(B1, 1, 1); PG8_SCHED; PG8_LDA(At, 1, 0); PG8_STAGE(PG8_SA(0, 1), a2 + hstep, voffA);
            PG8_WAIT_V(8); PG8_WAIT_L(0); PG8_BAR; PG8_MMA(0, 0, At, B0); PG8_MMA(0, 1, At, B1); PG8_BAR; PG8_SCHED;
            PG8_LDA(At, 1, 1); PG8_STAGE(PG8_SB(1, 0), b3, voffB); PG8_STAGE(PG8_SB(1, 1), b3 + hstep, voffB); PG8_STAGE(PG8_SA(1, 0), a3, voffA);
            PG8_WAIT_V(8); PG8_WAIT_L(0); PG8_BAR; PG8_MMA(1, 0, At, B0); PG8_MMA(1, 1, At, B1); PG8_BAR; PG8_SCHED;
            } else {
            PG8_LDB(B0, 0, 0); PG8_SCHED; PG8_LDA(At, 0, 0); PG8_STAGE(PG8_SA(1, 1), a1 + hstep, voffA);
            PG8_WAIT_L(8); PG8_BAR; PG8_WAIT_L(0); PG8_MMA(0, 0, At, B0); PG8_BAR; PG8_SCHED;
            PG8_LDB(B1, 0, 1); PG8_STAGE(PG8_SB(0, 0), b2, voffB);
            PG8_BAR; PG8_WAIT_L(0); PG8_MMA(0, 1, At, B1); PG8_BAR;
            PG8_LDA(At, 0, 1); PG8_STAGE(PG8_SA(0, 0), a2, voffA);
            PG8_BAR; PG8_WAIT_L(0); PG8_MMA(1, 0, At, B0); PG8_BAR; PG8_SCHED;
            PG8_STAGE(PG8_SB(0, 1), b2 + hstep, voffB);
            PG8_WAIT_V(6); PG8_BAR; PG8_MMA(1, 1, At, B1); PG8_BAR;
            PG8_LDB(B0, 1, 0); PG8_SCHED; PG8_LDA(At, 1, 0); PG8_STAGE(PG8_SA(0, 1), a2 + hstep, voffA);
            PG8_WAIT_L(8); PG8_BAR; PG8_WAIT_L(0); PG8_MMA(0, 0, At, B0); PG8_BAR; PG8_SCHED;
            PG8_LDB(B1, 1, 1); PG8_STAGE(PG8_SB(1, 0), b3, voffB);
            PG8_BAR; PG8_WAIT_L(0); PG8_MMA(0, 1, At, B1); PG8_BAR;
            PG8_LDA(At, 1, 1); PG8_STAGE(PG8_SA(1, 0), a3, voffA);
            PG8_BAR; PG8_WAIT_L(0); PG8_MMA(1, 0, At, B0); PG8_BAR; PG8_SCHED;
            PG8_STAGE(PG8_SB(1, 1), b3 + hstep, voffB);
            PG8_WAIT_V(6); PG8_BAR; PG8_MMA(1, 1, At, B1); PG8_BAR;
            }
        }
        if constexpr (ALIGN_EPI) { if (wr == 0) PG8_BAR; }
        if constexpr (!Epi::AFTER_DRAIN) { E(acc, cur, wr, wc, fr, fq); S.done(cur); }
        if (!has_next) break;
#pragma unroll
        for (int a = 0; a < 2; ++a)
#pragma unroll
            for (int b = 0; b < 2; ++b)
#pragma unroll
                for (int m = 0; m < 4; ++m)
#pragma unroll
                    for (int n = 0; n < 2; ++n) acc[a][b][m][n] = (f32x4){0.f, 0.f, 0.f, 0.f};
        cur = nxt; cA = nA; cB = nB; ++ui;
        if constexpr (ALIGN_EPI) { if (wr == 1) PG8_BAR; }
    }
    PG8_WAIT_V(0);
    if constexpr (!ALIGN_EPI) { if (wr == 0) PG8_BAR; }
    PG8_BAR;
    if constexpr (Epi::AFTER_DRAIN) { E.fused(acc, cur, wr, wc, fr, fq, lds, wid, lane); S.done(cur); }
#undef PG8_SA
#undef PG8_SB
#undef PG8_STAGE
#undef PG8_LDA
#undef PG8_LDB
#undef PG8_MMA
#undef PG8_WAIT_V
#undef PG8_WAIT_L
#undef PG8_BAR
#undef PG8_SCHED
}
}

#define LAS __attribute__((address_space(3)))
typedef unsigned short bf16;
typedef float f32x4 __attribute__((ext_vector_type(4)));
typedef short bf16x8 __attribute__((ext_vector_type(8)));
typedef unsigned u32x4 __attribute__((ext_vector_type(4)));
typedef unsigned u32x2 __attribute__((ext_vector_type(2)));

#ifndef MK_MULTI
#define MK_MULTI 0
#endif

constexpr int DM = 1024, NB = 8, SEQ = 8192, CTXL = 256, DFF = 4096;
constexpr int MLAT = NB * SEQ, MCTX = NB * CTXL, MALL = MLAT + MCTX;
constexpr int IN_DIM = 4144, INP = 4352;
constexpr int MODW = 6 * DM;
constexpr float EPS = 1e-6f;
constexpr int C_HG_Q = 0, C_HG_FF = 256, C_HG_FB = 512, C_HG_I = 768, C_HG_G = 1024, C_ML_Q = 1280, C_ML_K = 1536, C_ML_V = 1792, C_ML_IF = 2048, C_ML_O = 2064,
              C_RT_Q = 2320, C_RT_K = 2576, C_RT_V = 2832, C_RT_G = 3088, C_GL_Q = 3344, C_GL_K = 3472, C_GL_V = 3600, C_GL_AF = 3856, C_GL_AB = 3872, C_GL_G = 3888;
static_assert(C_GL_G + 256 == IN_DIM, "layout");

constexpr size_t MiB = 1u << 20;
constexpr size_t WIN_BYTES = (size_t)INP * DM * 2;
constexpr size_t WS_WIN = 2 * MiB, WS_WOUT = 20 * MiB, WS_WFF1 = 24 * MiB, WS_WFF2 = 40 * MiB, WS_MOD = 56 * MiB, WS_XC = 58 * MiB;
constexpr size_t WS_H = 66 * MiB;
constexpr size_t WS_YF = 198 * MiB;
constexpr size_t WS_P = 330 * MiB;
static_assert(WS_WIN + 2 * WIN_BYTES <= WS_WOUT, "ws map");
constexpr int LDS_BYTES = 147456;
constexpr int NPHASE = 15;
constexpr size_t WS_BIAS = 1 * MiB;
constexpr size_t WS_SS1 = 57 * MiB, WS_SS2 = WS_SS1 + 512 * 1024;

struct Params {
    const float *x, *c, *ctx, *c_ctx, *w_ada, *b_ada, *w_in, *g_heads, *lb_logits, *ml_bias, *rt_logit, *gla_w, *gla_b, *w_out, *w_ff1, *w_ff2, *g_final;
    float* out; unsigned char* ws; int ph_lo, ph_hi;
};

typedef __bf16 bf16x2v_ __attribute__((ext_vector_type(2)));
typedef float f32x2v_ __attribute__((ext_vector_type(2)));
__device__ __forceinline__ unsigned pk_bf16(float lo, float hi) { const f32x2v_ v = {lo, hi}; const bf16x2v_ b = __builtin_convertvector(v, bf16x2v_); return __builtin_bit_cast(unsigned, b); }
__device__ __forceinline__ void unpack8(const u32x4 w, float (&f)[8]) {
    f[0] = __uint_as_float(w.x << 16); f[1] = __uint_as_float(w.x & 0xffff0000u); f[2] = __uint_as_float(w.y << 16); f[3] = __uint_as_float(w.y & 0xffff0000u);
    f[4] = __uint_as_float(w.z << 16); f[5] = __uint_as_float(w.z & 0xffff0000u); f[6] = __uint_as_float(w.w << 16); f[7] = __uint_as_float(w.w & 0xffff0000u);
}
__device__ __forceinline__ u32x4 pack8(const float (&f)[8]) { u32x4 o; o.x = pk_bf16(f[0], f[1]); o.y = pk_bf16(f[2], f[3]); o.z = pk_bf16(f[4], f[5]); o.w = pk_bf16(f[6], f[7]); return o; }
__device__ __forceinline__ float wave_sum(float v) {
#pragma unroll
    for (int o = 1; o < 64; o <<= 1) v += __shfl_xor(v, o);
    return v;
}
__device__ __forceinline__ int tid_opaque() { int t = threadIdx.x; asm volatile("" : "+v"(t)); return t; }
__device__ __forceinline__ float sigmoidf_(float z) { return __builtin_amdgcn_rcpf(1.f + __expf(-z)); }
__device__ __forceinline__ float logsigmoidf_(float z) { return fminf(z, 0.f) - __logf(1.f + __expf(-fabsf(z))); }

template <int ACT, int LDC> struct EpiAct {
    static constexpr bool PERM = true, AFTER_DRAIN = false;
    bf16* O;
    __device__ __forceinline__ void operator()(const pg8::f32x4 (&acc)[2][2][4][2], const pg8::Unit& u, int wr, int wc, int fr, int fq) const {
        const int row0 = u.pm * 256 + wr * 64 + fr, col0 = u.pn * 256 + wc * 32 + 8 * fq;
#pragma unroll
        for (int ai = 0; ai < 2; ++ai)
#pragma unroll
            for (int m = 0; m < 4; ++m) { bf16* rowp = O + (size_t)(row0 + ai * 128 + m * 16) * LDC + col0;
#pragma unroll
                for (int bj = 0; bj < 2; ++bj) { pg8::f32x4 v0 = acc[ai][bj][m][0], v1 = acc[ai][bj][m][1];
                    if (ACT == 1) {
#pragma unroll
                        for (int j = 0; j < 4; ++j) { float a = fmaxf(v0[j], 0.f), b = fmaxf(v1[j], 0.f); v0[j] = a * a; v1[j] = b * b; } }
                    u32x4 w; w.x = pk_bf16(v0[0], v0[1]); w.y = pk_bf16(v0[2], v0[3]); w.z = pk_bf16(v1[0], v1[1]); w.w = pk_bf16(v1[2], v1[3]);
                    *(u32x4*)(rowp + bj * 128) = w; } }
    }
};
struct EpiResNorm {
    static constexpr bool PERM = false, AFTER_DRAIN = false;
    const float* base_lat; const float* base_ctx; float* out_lat; float* out_ctx; const float* gate; const float* scale; bf16* H; float* ss; int store_f32;
    __device__ __forceinline__ void prefetch(const pg8::Unit&, int, int, int, int) const {}
    __device__ __forceinline__ void operator()(const pg8::f32x4 (&acc)[2][2][4][2], const pg8::Unit& u, int wr, int wc, int fr, int fq) const {
        const bool isc = u.pm >= 256; const int pmr = isc ? u.pm - 256 : u.pm;
        const float* bp = isc ? base_ctx : base_lat; float* op = isc ? out_ctx : out_lat;
        const int col0 = u.pn * 256 + wc * 32 + 4 * fq;
        const size_t off0 = (size_t)(pmr * 256 + wr * 64 + fr) * DM + col0, grow0 = (size_t)u.pm * 256 + wr * 64 + fr;
        const int brow = isc ? 8 : (u.pm >> 5);
        f32x4 gv[2][2], sv[2][2];
#pragma unroll
        for (int bj = 0; bj < 2; ++bj)
#pragma unroll
            for (int n = 0; n < 2; ++n) { gv[bj][n] = *(const f32x4*)(gate + brow * MODW + col0 + bj * 128 + n * 16); sv[bj][n] = scale ? *(const f32x4*)(scale + brow * MODW + col0 + bj * 128 + n * 16) : (f32x4){0.f, 0.f, 0.f, 0.f}; }
        f32x4 cur[2][2], nxt[2][2];
#pragma unroll
        for (int bj = 0; bj < 2; ++bj)
#pragma unroll
            for (int n = 0; n < 2; ++n) cur[bj][n] = *(const f32x4*)(bp + off0 + bj * 128 + n * 16);
#pragma unroll
        for (int g = 0; g < 8; ++g) { const int rl = (g >> 2) * 128 + (g & 3) * 16; const size_t off = off0 + (size_t)rl * DM, grow = grow0 + rl;
            if (g < 7) { const int rl2 = ((g + 1) >> 2) * 128 + ((g + 1) & 3) * 16;
#pragma unroll
                for (int bj = 0; bj < 2; ++bj)
#pragma unroll
                    for (int n = 0; n < 2; ++n) nxt[bj][n] = *(const f32x4*)(bp + off0 + (size_t)rl2 * DM + bj * 128 + n * 16); }
            asm volatile("" ::: "memory");
            float sq = 0.f;
#pragma unroll
            for (int bj = 0; bj < 2; ++bj)
#pragma unroll
                for (int n = 0; n < 2; ++n) { const f32x4 o = cur[bj][n] + gv[bj][n] * acc[g >> 2][bj][g & 3][n];
                    if (store_f32) *(f32x4*)(op + off + bj * 128 + n * 16) = o; sq += (o.x * o.x + o.y * o.y) + (o.z * o.z + o.w * o.w);
                    if (H) { const f32x4 xs = o * (sv[bj][n] + 1.f); u32x2 wv; wv.x = pk_bf16(xs.x, xs.y); wv.y = pk_bf16(xs.z, xs.w); *(u32x2*)(H + grow * DM + col0 + bj * 128 + n * 16) = wv; } }
            sq += __shfl_xor(sq, 16); sq += __shfl_xor(sq, 32);
            if (fq == 0) atomicAdd(ss + grow, sq);
            asm volatile("" ::: "memory");
#pragma unroll
            for (int bj = 0; bj < 2; ++bj)
#pragma unroll
                for (int n = 0; n < 2; ++n) cur[bj][n] = nxt[bj][n]; }
    }
};
template <int ACT, int LDC> struct EpiNormAct {
    static constexpr bool PERM = true, AFTER_DRAIN = false;
    bf16* O; const float* ss; const float* bias;
    mutable float rs[8];
    __device__ __forceinline__ void prefetch(const pg8::Unit& u, int wr, int wc, int fr, int fq) const {
        const int row0 = u.pm * 256 + wr * 64 + fr, col0 = u.pn * 256 + wc * 32 + 8 * fq;
#pragma unroll
        for (int i = 0; i < 8; ++i) rs[i] = ss[row0 + (i >> 2) * 128 + (i & 3) * 16];
    }
    __device__ __forceinline__ void operator()(const pg8::f32x4 (&acc)[2][2][4][2], const pg8::Unit& u, int wr, int wc, int fr, int fq) const {
        const int row0 = u.pm * 256 + wr * 64 + fr, col0 = u.pn * 256 + wc * 32 + 8 * fq;
        const float* bp = bias + (u.pm >= 256 ? 8 : (u.pm >> 5)) * INP + col0;
        f32x4 bv[2][2];
#pragma unroll
        for (int bj = 0; bj < 2; ++bj) { bv[bj][0] = *(const f32x4*)(bp + bj * 128); bv[bj][1] = *(const f32x4*)(bp + bj * 128 + 4); }
#pragma unroll
        for (int ai = 0; ai < 2; ++ai)
#pragma unroll
            for (int m = 0; m < 4; ++m) { const int row = row0 + ai * 128 + m * 16; const float r = rsqrtf(rs[ai * 4 + m] * (1.f / DM) + EPS); bf16* rowp = O + (size_t)row * LDC + col0;
#pragma unroll
                for (int bj = 0; bj < 2; ++bj) { pg8::f32x4 v0 = acc[ai][bj][m][0] * r + bv[bj][0], v1 = acc[ai][bj][m][1] * r + bv[bj][1];
                    if (ACT == 1) {
#pragma unroll
                        for (int j = 0; j < 4; ++j) { float a = fmaxf(v0[j], 0.f), b = fmaxf(v1[j], 0.f); v0[j] = a * a; v1[j] = b * b; } }
                    u32x4 w; w.x = pk_bf16(v0[0], v0[1]); w.y = pk_bf16(v0[2], v0[3]); w.z = pk_bf16(v1[0], v1[1]); w.w = pk_bf16(v1[2], v1[3]);
                    *(u32x4*)(rowp + bj * 128) = w; } }
    }
};

__device__ __forceinline__ void transpose_item(const float* W, int K, int N, int Npad, bf16* WT, LAS float* scr, int item, int lane) {
    const int nblk = Npad / 32, kb = item / nblk, nb = item % nblk, k0 = 64 * kb, n0 = 32 * nb;
    const int n = n0 + (lane & 31);
    float wv[32];
#pragma unroll
    for (int i = 0; i < 32; ++i) { const int kk = 2 * i + (lane >> 5); wv[i] = n < N ? W[(size_t)(k0 + kk) * N + n] : 0.f; }
#pragma unroll
    for (int i = 0; i < 32; ++i) { const int kk = 2 * i + (lane >> 5); scr[kk * 33 + (lane & 31)] = wv[i]; }
    asm volatile("s_waitcnt lgkmcnt(0)" ::: "memory");
    const int c = lane & 7;
#pragma unroll
    for (int j = 0; j < 4; ++j) { const int nn = (lane >> 3) + 8 * j; const LAS float* s = scr + (8 * c) * 33 + nn;
        u32x4 o; o.x = pk_bf16(s[0 * 33], s[1 * 33]); o.y = pk_bf16(s[2 * 33], s[3 * 33]); o.z = pk_bf16(s[4 * 33], s[5 * 33]); o.w = pk_bf16(s[6 * 33], s[7 * 33]);
        *(u32x4*)(WT + (size_t)(n0 + nn) * K + k0 + 8 * c) = o; }
    asm volatile("s_waitcnt lgkmcnt(0)" ::: "memory");
}
__device__ __forceinline__ void prologue_phase(const Params& p, LAS unsigned char* lds) {
    const int tid = tid_opaque(), lane = tid & 63, wave = tid >> 6;
    LAS float* scs = (LAS float*)lds;
    LAS float* part = (LAS float*)(lds + 36864);
    float* mod = (float*)(p.ws + WS_MOD);
    bool staged = false;
    for (int item = blockIdx.x; item < 192; item += gridDim.x) {
        if (!staged) { for (int i = tid; i < 9 * 1024; i += 512) { const int r = i >> 10, k = i & 1023; const float v = r < 8 ? p.c[r * 1024 + k] : p.c_ctx[k]; scs[i] = v / (1.f + __expf(-v)); } __syncthreads(); staged = true; }
        const int l = item / 96, n0 = (item % 96) * 64;
        const float* W = p.w_ada + (size_t)l * DM * MODW + n0 + lane;
        float acc[9];
#pragma unroll
        for (int r = 0; r < 9; ++r) acc[r] = 0.f;
        const int k0 = wave * 128;
#pragma unroll 16
        for (int k = k0; k < k0 + 128; ++k) { const float wv = W[(size_t)k * MODW];
#pragma unroll
            for (int r = 0; r < 9; ++r) acc[r] += scs[r * 1024 + k] * wv; }
#pragma unroll
        for (int r = 0; r < 9; ++r) part[(wave * 9 + r) * 64 + lane] = acc[r];
        __syncthreads();
        for (int i = tid; i < 576; i += 512) { const int r = i >> 6, ln = i & 63; float s = p.b_ada[l * MODW + n0 + ln];
#pragma unroll
            for (int w2 = 0; w2 < 8; ++w2) s += part[(w2 * 9 + r) * 64 + ln];
            mod[(size_t)(l * 9 + r) * MODW + n0 + ln] = s; }
        __syncthreads();
    }
    __syncthreads();
    LAS float* scr = (LAS float*)(lds + wave * 16384);
    const int gw = blockIdx.x * 8 + wave, NGW = gridDim.x * 8;
    constexpr int I_IN = 16 * (INP / 32), I_OUT = 16 * 32, I_F1 = 16 * (DFF / 32), I_F2 = (DFF / 64) * 32, PER_L = I_IN + I_OUT + I_F1 + I_F2;
    for (int it = gw; it < PER_L; it += NGW) {
        const int l = 0; int r = it;
        if (r < I_IN) { transpose_item(p.w_in + (size_t)l * DM * IN_DIM, DM, IN_DIM, INP, (bf16*)(p.ws + WS_WIN + l * WIN_BYTES), scr, r, lane); continue; } r -= I_IN;
        if (r < I_OUT) { transpose_item(p.w_out + (size_t)l * DM * DM, DM, DM, DM, (bf16*)(p.ws + WS_WOUT + l * 2 * MiB), scr, r, lane); continue; } r -= I_OUT;
        if (r < I_F1) { transpose_item(p.w_ff1 + (size_t)l * DM * DFF, DM, DFF, DFF, (bf16*)(p.ws + WS_WFF1 + l * 8 * MiB), scr, r, lane); continue; } r -= I_F1;
        transpose_item(p.w_ff2 + (size_t)l * DFF * DM, DFF, DM, DM, (bf16*)(p.ws + WS_WFF2 + l * 8 * MiB), scr, r, lane);
    }
}

__device__ __forceinline__ void prep_layer1_weights(const Params& p, LAS unsigned char* lds, int first_blk) {
    const int tid = tid_opaque(), lane = tid & 63, wave = tid >> 6;
    if ((int)blockIdx.x < first_blk) return;
    LAS float* scr = (LAS float*)(lds + wave * 16384);
    const int gw = ((int)blockIdx.x - first_blk) * 8 + wave, NGW = ((int)gridDim.x - first_blk) * 8;
    constexpr int I_IN = 16 * (INP / 32), I_OUT = 16 * 32, I_F1 = 16 * (DFF / 32), I_F2 = (DFF / 64) * 32, PER_L = I_IN + I_OUT + I_F1 + I_F2;
    const int l = 1;
    for (int it = gw; it < PER_L; it += NGW) {
        int r = it;
        if (r < I_IN) { transpose_item(p.w_in + (size_t)l * DM * IN_DIM, DM, IN_DIM, INP, (bf16*)(p.ws + WS_WIN + l * WIN_BYTES), scr, r, lane); continue; } r -= I_IN;
        if (r < I_OUT) { transpose_item(p.w_out + (size_t)l * DM * DM, DM, DM, DM, (bf16*)(p.ws + WS_WOUT + l * 2 * MiB), scr, r, lane); continue; } r -= I_OUT;
        if (r < I_F1) { transpose_item(p.w_ff1 + (size_t)l * DM * DFF, DM, DFF, DFF, (bf16*)(p.ws + WS_WFF1 + l * 8 * MiB), scr, r, lane); continue; } r -= I_F1;
        transpose_item(p.w_ff2 + (size_t)l * DFF * DM, DFF, DM, DM, (bf16*)(p.ws + WS_WFF2 + l * 8 * MiB), scr, r, lane);
    }
}
__device__ __forceinline__ void init_scale_phase(const float* src_lat, const float* src_ctx, const float* modl, int scoff, bf16* H, float* ss) {
    const int tid = tid_opaque(), lane = tid & 63, gw = blockIdx.x * 8 + (tid >> 6), NGW = gridDim.x * 8;
    for (int m0 = gw * 4; m0 < MALL; m0 += NGW * 4) {
        const float* xr = m0 < MLAT ? src_lat + (size_t)m0 * DM : src_ctx + (size_t)(m0 - MLAT) * DM;
        const float* mr = modl + (m0 < MLAT ? (m0 >> 13) : 8) * MODW;
        f32x4 v[4][4];
#pragma unroll
        for (int rr = 0; rr < 4; ++rr)
#pragma unroll
            for (int j = 0; j < 4; ++j) v[rr][j] = ((const f32x4*)(xr + (size_t)rr * DM))[64 * j + lane];
        f32x4 sc[4];
#pragma unroll
        for (int j = 0; j < 4; ++j) sc[j] = *(const f32x4*)(mr + scoff + 256 * j + 4 * lane) + 1.f;
#pragma unroll
        for (int rr = 0; rr < 4; ++rr) { float sq = 0.f;
#pragma unroll
            for (int j = 0; j < 4; ++j) sq += (v[rr][j].x * v[rr][j].x + v[rr][j].y * v[rr][j].y) + (v[rr][j].z * v[rr][j].z + v[rr][j].w * v[rr][j].w);
            sq = wave_sum(sq); if (lane == 0) ss[m0 + rr] = sq;
#pragma unroll
            for (int j = 0; j < 4; ++j) { const f32x4 o = v[rr][j] * sc[j]; u32x2 wv; wv.x = pk_bf16(o.x, o.y); wv.y = pk_bf16(o.z, o.w); *(u32x2*)(H + (size_t)(m0 + rr) * DM + 256 * j + 4 * lane) = wv; } }
    }
}
__device__ __forceinline__ void bias_gemv_phase(const Params& p, LAS unsigned char* lds, const int lsel, const int first_blk) {
    const int tid = tid_opaque(), lane = tid & 63, wave = tid >> 6;
    LAS float* shs = (LAS float*)lds;
    LAS float* part = (LAS float*)(lds + 36864);
    const float* mod = (const float*)(p.ws + WS_MOD); float* bias = (float*)(p.ws + WS_BIAS);
    if ((int)blockIdx.x < first_blk) return;
    for (int item = (int)blockIdx.x - first_blk; item < 132; item += (int)gridDim.x - first_blk) {
        const int l = lsel, r0 = item, which = r0 < 68 ? 0 : 1, grp = which ? r0 - 68 : r0, n0 = grp * 64;
        const int N = which ? DFF : IN_DIM, shoff = which ? 3 * DM : 0;
        const float* W = which ? p.w_ff1 + (size_t)l * DM * DFF : p.w_in + (size_t)l * DM * IN_DIM;
        __syncthreads();
        for (int i = tid; i < 9 * 1024; i += 512) shs[i] = mod[(size_t)(l * 9 + (i >> 10)) * MODW + shoff + (i & 1023)];
        __syncthreads();
        const int n = n0 + lane; const bool valid = n < N;
        float acc[9];
#pragma unroll
        for (int r = 0; r < 9; ++r) acc[r] = 0.f;
        const int k0 = wave * 128;
        if (n0 < N) {
#pragma unroll 16
            for (int k = k0; k < k0 + 128; ++k) { const float wv = valid ? W[(size_t)k * N + n] : 0.f;
#pragma unroll
                for (int r = 0; r < 9; ++r) acc[r] += shs[r * 1024 + k] * wv; } }
#pragma unroll
        for (int r = 0; r < 9; ++r) part[(wave * 9 + r) * 64 + lane] = acc[r];
        __syncthreads();
        for (int i = tid; i < 576; i += 512) { const int r = i >> 6, ln = i & 63; float sm = 0.f;
#pragma unroll
            for (int w2 = 0; w2 < 8; ++w2) sm += part[(w2 * 9 + r) * 64 + ln];
            bias[(size_t)((l * 2 + which) * 9 + r) * INP + n0 + ln] = sm; }
    }
    __syncthreads();
}
__device__ __forceinline__ void norm_phase(const float* src_lat, const float* src_ctx, const float* modl, int shoff, int scoff, bf16* H, int nrows) {
    const int tid = tid_opaque(), lane = tid & 63, gw = blockIdx.x * 8 + (tid >> 6), NGW = gridDim.x * 8;
    for (int m0 = gw * 4; m0 < nrows; m0 += NGW * 4) {
        const float* xr = m0 < MLAT ? src_lat + (size_t)m0 * DM : src_ctx + (size_t)(m0 - MLAT) * DM;
        const float* mr = modl + (m0 < MLAT ? (m0 >> 13) : 8) * MODW;
        f32x4 v[4][4];
#pragma unroll
        for (int rr = 0; rr < 4; ++rr)
#pragma unroll
            for (int j = 0; j < 4; ++j) v[rr][j] = ((const f32x4*)(xr + (size_t)rr * DM))[64 * j + lane];
        f32x4 sh[4], sc[4];
#pragma unroll
        for (int j = 0; j < 4; ++j) { const int col = 256 * j + 4 * lane; sh[j] = *(const f32x4*)(mr + shoff + col); sc[j] = *(const f32x4*)(mr + scoff + col) + 1.f; }
#pragma unroll
        for (int rr = 0; rr < 4; ++rr) { float ss = 0.f;
#pragma unroll
            for (int j = 0; j < 4; ++j) ss += (v[rr][j].x * v[rr][j].x + v[rr][j].y * v[rr][j].y) + (v[rr][j].z * v[rr][j].z + v[rr][j].w * v[rr][j].w);
            const float r = rsqrtf(wave_sum(ss) * (1.f / DM) + EPS);
#pragma unroll
            for (int j = 0; j < 4; ++j) { const int col = 256 * j + 4 * lane; const f32x4 o = v[rr][j] * r * sc[j] + sh[j];
                u32x2 wv; wv.x = pk_bf16(o.x, o.y); wv.y = pk_bf16(o.z, o.w); *(u32x2*)(H + (size_t)(m0 + rr) * DM + col) = wv; } }
    }
}
__device__ __forceinline__ void final_norm_phase(float* xo, const bf16* xb, const float* gfin, const float* ss) {
    const int tid = tid_opaque(), lane = tid & 63, gw = blockIdx.x * 8 + (tid >> 6), NGW = gridDim.x * 8;
    f32x4 g[4];
#pragma unroll
    for (int j = 0; j < 4; ++j) g[j] = ((const f32x4*)gfin)[64 * j + lane];
    for (int m0 = gw * 4; m0 < MLAT; m0 += NGW * 4) {
        u32x2 v[4][4]; float r[4];
#pragma unroll
        for (int rr = 0; rr < 4; ++rr) { r[rr] = rsqrtf(ss[m0 + rr] * (1.f / DM) + EPS);
#pragma unroll
            for (int j = 0; j < 4; ++j) v[rr][j] = *(const u32x2*)(xb + (size_t)(m0 + rr) * DM + 256 * j + 4 * lane); }
#pragma unroll
        for (int rr = 0; rr < 4; ++rr)
#pragma unroll
            for (int j = 0; j < 4; ++j) { const u32x2 w = v[rr][j];
                const f32x4 x = {__uint_as_float(w.x << 16), __uint_as_float(w.x & 0xffff0000u), __uint_as_float(w.y << 16), __uint_as_float(w.y & 0xffff0000u)};
                ((f32x4*)(xo + (size_t)(m0 + rr) * DM))[64 * j + lane] = x * r[rr] * g[j]; }
    }
}
__device__ __forceinline__ void gate_phase(const Params& p, int layer, int nrows) {
    const int tid = tid_opaque(), lane = tid & 63, gw = blockIdx.x * 8 + (tid >> 6), NGW = gridDim.x * 8;
    bf16* YF = (bf16*)(p.ws + WS_YF); const bf16* YB = (const bf16*)(p.ws + WS_H); const bf16* P = (const bf16*)(p.ws + WS_P);
    const float* gh = p.g_heads + layer * DM;
    { float* ss1 = (float*)(p.ws + WS_SS1); float* ss2 = (float*)(p.ws + WS_SS2); for (int i = blockIdx.x * 512 + tid; i < MALL; i += gridDim.x * 512) { ss1[i] = 0.f; ss2[i] = 0.f; } }
    float ghv[2][8];
#pragma unroll
    for (int g2 = 0; g2 < 2; ++g2) { const int c = g2 * 512 + lane * 8; const f32x4 g0 = *(const f32x4*)(gh + c), g1 = *(const f32x4*)(gh + c + 4);
        ghv[g2][0] = g0.x; ghv[g2][1] = g0.y; ghv[g2][2] = g0.z; ghv[g2][3] = g0.w; ghv[g2][4] = g1.x; ghv[g2][5] = g1.y; ghv[g2][6] = g1.z; ghv[g2][7] = g1.w; }
    for (int m0 = gw * 4; m0 < nrows; m0 += NGW * 4) {
        u32x4 a[4][2], b[4][2], gt[4][2];
#pragma unroll
        for (int rr = 0; rr < 4; ++rr)
#pragma unroll
            for (int g2 = 0; g2 < 2; ++g2) { const int c = g2 * 512 + lane * 8, mix = c >> 8; const size_t m = (size_t)(m0 + rr);
                const int gcol = (mix == 0 ? C_HG_G : mix == 1 ? C_ML_O : mix == 2 ? C_RT_G : C_GL_G) + (c & 255);
                a[rr][g2] = *(const u32x4*)(YF + m * DM + c); b[rr][g2] = *(const u32x4*)(YB + m * DM + c); gt[rr][g2] = *(const u32x4*)(P + m * INP + gcol); }
#pragma unroll
        for (int rr = 0; rr < 4; ++rr)
#pragma unroll
            for (int g2 = 0; g2 < 2; ++g2) { const int c = g2 * 512 + lane * 8, mix = c >> 8;
                float ya[8], yb[8], gg[8], o[8]; unpack8(a[rr][g2], ya); unpack8(b[rr][g2], yb); unpack8(gt[rr][g2], gg);
                float ss = 0.f;
#pragma unroll
                for (int e = 0; e < 8; ++e) { ya[e] += yb[e]; ss += ya[e] * ya[e]; }
                ss += __shfl_xor(ss, 1); ss += __shfl_xor(ss, 2); ss += __shfl_xor(ss, 4);
                const float r = rsqrtf(ss * (1.f / 64.f) + EPS);
#pragma unroll
                for (int e = 0; e < 8; ++e) { const float sg = sigmoidf_(gg[e]); const float gate = mix < 2 ? sg : gg[e] * sg; o[e] = ya[e] * r * ghv[g2][e] * gate; }
                *(u32x4*)(YF + (size_t)(m0 + rr) * DM + c) = pack8(o); }
    }
}

constexpr int RS = 72;
constexpr int L_BUF = 46336, L_QM = 0, L_QD = 9216, L_KM = 18432, L_KET = 27648, L_VT = 36864, L_DL = 46080;
constexpr int L_ST = 92672, L_AT = 111104, L_DEN = 120320, L_NST = 120576, L_WA = 120832, L_BA = 122880, L_LB = 123136, L_COLC = 123392, L_COLS = 127488, L_ROWT = 131584;
static_assert(L_ROWT + 256 <= LDS_BYTES - 128, "scan LDS map");
__device__ __forceinline__ void sincos_red(float pos, float inv, float& sn, float& cs) {
    const float angf = pos * inv; const float n = rintf(angf * 0.15915494309189535f);
    float y = fmaf(-n, 6.28125f, angf); y = fmaf(-n, 1.9353071795864769e-3f, y);
    sn = __sinf(y); cs = __cosf(y);
}
__device__ __forceinline__ unsigned short bf1(float x) { return (unsigned short)(pk_bf16(x, 0.f) & 0xffffu); }
__device__ __forceinline__ float rdlane(float v, int l) { return __int_as_float(__builtin_amdgcn_readlane(__float_as_int(v), l)); }
#define DPPF(x, ctrl, rmask) __int_as_float(__builtin_amdgcn_update_dpp(0, __float_as_int(x), (ctrl), (rmask), 0xf, false))
__device__ __forceinline__ float wave_incl_scan(float x) {
    x += DPPF(x, 0x111, 0xf); x += DPPF(x, 0x112, 0xf); x += DPPF(x, 0x114, 0xf); x += DPPF(x, 0x118, 0xf);
    x += DPPF(x, 0x142, 0xa); x += DPPF(x, 0x143, 0xc);
    return x;
}
__device__ __forceinline__ void wave_incl_scan8(float (&x)[8]) {
#pragma unroll
    for (int e = 0; e < 8; ++e) x[e] += DPPF(x[e], 0x111, 0xf);
#pragma unroll
    for (int e = 0; e < 8; ++e) x[e] += DPPF(x[e], 0x112, 0xf);
#pragma unroll
    for (int e = 0; e < 8; ++e) x[e] += DPPF(x[e], 0x114, 0xf);
#pragma unroll
    for (int e = 0; e < 8; ++e) x[e] += DPPF(x[e], 0x118, 0xf);
#pragma unroll
    for (int e = 0; e < 8; ++e) x[e] += DPPF(x[e], 0x142, 0xa);
#pragma unroll
    for (int e = 0; e < 8; ++e) x[e] += DPPF(x[e], 0x143, 0xc);
}
template <int N> __device__ __forceinline__ void wave_incl_scanN(float (&x)[8]) {
#pragma unroll
    for (int e = 0; e < N; ++e) x[e] += DPPF(x[e], 0x111, 0xf);
#pragma unroll
    for (int e = 0; e < N; ++e) x[e] += DPPF(x[e], 0x112, 0xf);
#pragma unroll
    for (int e = 0; e < N; ++e) x[e] += DPPF(x[e], 0x114, 0xf);
#pragma unroll
    for (int e = 0; e < N; ++e) x[e] += DPPF(x[e], 0x118, 0xf);
#pragma unroll
    for (int e = 0; e < N; ++e) x[e] += DPPF(x[e], 0x142, 0xa);
#pragma unroll
    for (int e = 0; e < N; ++e) x[e] += DPPF(x[e], 0x143, 0xc);
}
#define LBAR() do { asm volatile("s_waitcnt lgkmcnt(0)" ::: "memory"); __builtin_amdgcn_s_barrier(); asm volatile("" ::: "memory"); } while (0)

template <int MIX>
__device__ __forceinline__ void scan_chain(const Params& p, const int layer, const bool last, const int b, const int h, const int d, LAS unsigned char* lds) {
    const int tid = tid_opaque(), lane = tid & 63, w = tid >> 6, fr = lane & 15, fq = lane >> 4;
    const int gs = lane, c0 = w * 8;
    constexpr int NQ = MIX == 3 ? 4 : 8;
    const int cq0 = MIX == 3 ? w * 4 : w * 8;
    const int ds = tid >> 3, dc0 = (tid & 7) * 8;
    const bf16* P = (const bf16*)(p.ws + WS_P);
    bf16* Y = (bf16*)(p.ws + (d ? WS_H : WS_YF));
    LAS bf16* AT = (LAS bf16*)(lds + L_AT);
    LAS float* DEN = (LAS float*)(lds + L_DEN); LAS float* NST = (LAS float*)(lds + L_NST);
    LAS float* WA = (LAS float*)(lds + L_WA); LAS float* BA = (LAS float*)(lds + L_BA); LAS float* COLC = (LAS float*)(lds + L_COLC); LAS float* COLS = (LAS float*)(lds + L_COLS);
    LAS float* LBV = (LAS float*)(lds + L_LB); LAS float* ROWT = (LAS float*)(lds + L_ROWT);
    for (int i = tid; i < 64 * RS / 2; i += 512) ((LAS unsigned*)(lds + L_ST))[i] = 0u;
    if (tid < 64) NST[tid] = 0.f;
    float cA = 0.f, cB = 0.f;
    if (MIX == 0) { if (tid < 64) { const int ch = h * 64 + tid; const float l0 = p.lb_logits[(0 * 2 + d) * 256 + ch], l1 = p.lb_logits[(1 * 2 + d) * 256 + ch]; const float mx = fmaxf(l0, l1);
            const float e0 = __expf(l0 - mx), e1 = __expf(l1 - mx), sm0 = e0 / (e0 + e1), sm1 = e1 / (e0 + e1); LBV[tid] = layer == 0 ? 0.f : fmaxf((sm0 + sm1) - sm0, 0.f); } }
    if (MIX == 1) { cA = p.ml_bias[((layer * 2 + d) * 2 + 0) * 4 + h]; cB = p.ml_bias[((layer * 2 + d) * 2 + 1) * 4 + h]; }
    if (MIX == 2) { cA = logsigmoidf_(p.rt_logit[(layer * 2 + d) * 4 + h]);
        for (int i = tid; i < 1024; i += 512) { const int j = i >> 4, fi = i & 15; const float inv = exp2f(-(float)fi * (13.287712379549449f / 16.f)); float sn, cs; sincos_red((float)j, inv, sn, cs); COLC[fi * 64 + j] = cs; COLS[fi * 64 + j] = sn; } }
    if (MIX == 3) { for (int i = tid; i < 2 * L_BUF / 4; i += 512) ((LAS unsigned*)lds)[i] = 0u;
        __syncthreads();
        if (tid < 32) { ((LAS float*)(lds + L_DL))[32 + tid] = 1.f; ((LAS float*)(lds + L_BUF + L_DL))[32 + tid] = 1.f; }
        { const int r = tid >> 5, c = tid & 31; WA[tid] = p.gla_w[((size_t)(layer * 2 + d) * 16 + r) * 128 + h * 32 + c]; } if (tid < 32) BA[tid] = p.gla_b[(layer * 2 + d) * 128 + h * 32 + tid]; }
    __syncthreads();
    float lbv[8];
#pragma unroll
    for (int e = 0; e < 8; ++e) lbv[e] = MIX == 0 ? LBV[c0 + e] : 0.f;
    float invf[8];
#pragma unroll
    for (int e = 0; e < 8; ++e) invf[e] = MIX == 2 ? exp2f(-(float)((w & 1) * 8 + e) * (13.287712379549449f / 16.f)) : 0.f;

    f32x4 S0 = {0.f, 0.f, 0.f, 0.f}, S1 = {0.f, 0.f, 0.f, 0.f};
    const int vt = w & 3, tp = (w >> 2) * 2;
    const int ycol = MIX * 256 + h * 64;
    u32x4 ra = {0u, 0u, 0u, 0u}, rb = ra, rc = ra, rd = ra, re = ra;

#define SCAN_LOAD(ii) do { const int i_ = (ii); const bool ic_ = i_ < 4; const int ci_ = ic_ ? i_ : i_ - 4; const int nch_ = ic_ ? 4 : 128; const int cx_ = d ? nch_ - 1 - ci_ : ci_; \
        const int row_ = (ic_ ? MLAT + b * CTXL : b * SEQ) + cx_ * 64 + (d ? 63 - gs : gs); const bf16* rp_ = P + (size_t)row_ * INP; \
        if (MIX == 0) { ra = *(const u32x4*)(rp_ + C_HG_Q + h * 64 + c0); rb = *(const u32x4*)(rp_ + (d ? C_HG_FB : C_HG_FF) + h * 64 + c0); rc = *(const u32x4*)(rp_ + C_HG_I + h * 64 + c0); } \
        if (MIX == 1) { ra = *(const u32x4*)(rp_ + C_ML_Q + h * 64 + c0); rb = *(const u32x4*)(rp_ + C_ML_K + h * 64 + c0); rc = *(const u32x4*)(rp_ + C_ML_V + h * 64 + c0); rd = *(const u32x4*)(rp_ + C_ML_IF + d * 8); } \
        if (MIX == 2) { ra = *(const u32x4*)(rp_ + C_RT_Q + h * 64 + c0); rb = *(const u32x4*)(rp_ + C_RT_K + h * 64 + c0); rc = *(const u32x4*)(rp_ + C_RT_V + h * 64 + c0); \
                        rd = *(const u32x4*)(rp_ + C_RT_Q + h * 64 + (c0 ^ 16)); re = *(const u32x4*)(rp_ + C_RT_K + h * 64 + (c0 ^ 16)); } \
        if (MIX == 3) { { const u32x2 t_ = *(const u32x2*)(rp_ + C_GL_Q + h * 32 + cq0); ra.x = t_.x; ra.y = t_.y; } { const u32x2 t_ = *(const u32x2*)(rp_ + C_GL_K + h * 32 + cq0); rb.x = t_.x; rb.y = t_.y; } \
                        rd = *(const u32x4*)(rp_ + (d ? C_GL_AB : C_GL_AF)); re = *(const u32x4*)(rp_ + (d ? C_GL_AB : C_GL_AF) + 8); \
                        rc = *(const u32x4*)(rp_ + C_GL_V + h * 64 + c0); } \
    } while (0)

    SCAN_LOAD(0);
    for (int i = -1; i < 132; ++i) {
        const bool is_ctx = i < 4; const int ci = is_ctx ? i : i - 4; const int nch = is_ctx ? 4 : 128; const int cidx = d ? nch - 1 - ci : ci;
        const int base = (is_ctx ? MLAT + b * CTXL : b * SEQ) + cidx * 64;
        LAS unsigned char* bufc = lds + (i & 1) * L_BUF;
        LAS bf16* QM = (LAS bf16*)(bufc + L_QM); LAS bf16* QD = (LAS bf16*)(bufc + L_QD); LAS bf16* KM = (LAS bf16*)(bufc + L_KM); LAS bf16* KET = (LAS bf16*)(bufc + L_KET);
        LAS bf16* VT = (LAS bf16*)(bufc + L_VT); LAS float* DL = (LAS float*)(bufc + L_DL);
        LAS bf16* STc = (LAS bf16*)(lds + L_ST + (i & 1) * 9216); LAS bf16* STn = (LAS bf16*)(lds + L_ST + ((i + 1) & 1) * 9216);
        if (i >= 0) {
#pragma unroll
        for (int ti = 0; ti < 2; ++ti) { const int tt = tp + ti; f32x4 acc = {0.f, 0.f, 0.f, 0.f};
#pragma unroll
            for (int kk = 0; kk < 2; ++kk) { const bf16x8 a = *(const LAS bf16x8*)(KM + (vt * 16 + fr) * RS + kk * 32 + fq * 8); const bf16x8 bq = *(const LAS bf16x8*)(QM + (tt * 16 + fr) * RS + kk * 32 + fq * 8);
                acc = __builtin_amdgcn_mfma_f32_16x16x32_bf16(a, bq, acc, 0, 0, 0); }
            const int tg = tt * 16 + fr, s0 = vt * 16 + fq * 4;
            const float o0 = (s0 + 0 <= tg) ? acc[0] : 0.f, o1 = (s0 + 1 <= tg) ? acc[1] : 0.f, o2 = (s0 + 2 <= tg) ? acc[2] : 0.f, o3 = (s0 + 3 <= tg) ? acc[3] : 0.f;
            u32x2 wv; wv.x = pk_bf16(o0, o1); wv.y = pk_bf16(o2, o3); *(LAS u32x2*)(AT + tg * RS + s0) = wv; }
        }
        if (i + 1 < 132) {
            const int j = i + 1;
            const bool is_ctx = j < 4; const int ci = is_ctx ? j : j - 4; const int nch = is_ctx ? 4 : 128; const int cidx = d ? nch - 1 - ci : ci;
            LAS unsigned char* bufc = lds + (j & 1) * L_BUF;
            LAS bf16* QM = (LAS bf16*)(bufc + L_QM); LAS bf16* QD = (LAS bf16*)(bufc + L_QD); LAS bf16* KM = (LAS bf16*)(bufc + L_KM); LAS bf16* KET = (LAS bf16*)(bufc + L_KET);
            LAS bf16* VT = (LAS bf16*)(bufc + L_VT); LAS float* DL = (LAS float*)(bufc + L_DL);
            (void)cidx; (void)QD; (void)KM;
        float q[8], k[8], v[8], la[8];
        unpack8(ra, q); unpack8(rb, k); unpack8(rc, v);
        const u32x4 rd0 = rd, re0 = re;
        if (j + 1 < 132) SCAN_LOAD(j + 1);
        if (MIX == 0) {
#pragma unroll
            for (int e = 0; e < 8; ++e) { const float z = k[e], qr = q[e]; q[e] = qr * __builtin_amdgcn_rcpf(1.f + __expf(-qr));
                const float ez = __expf(-fabsf(z)), i1 = __builtin_amdgcn_rcpf(1.f + ez), ei = ez * i1; const float sp = z >= 0.f ? i1 : ei, sn = z >= 0.f ? ei : i1;
                const float om = 1.f - lbv[e], f = lbv[e] + om * sp;
                la[e] = __logf(fmaxf(f, 1e-37f)); k[e] = om * sn; }
        }
        if (MIX == 1) {
            float g8[8]; unpack8(rd0, g8);
            const float pi = (h == 0 ? g8[0] : h == 1 ? g8[1] : h == 2 ? g8[2] : g8[3]) + cA, pf = (h == 0 ? g8[4] : h == 1 ? g8[5] : h == 2 ? g8[6] : g8[7]) + cB;
            const float lf = logsigmoidf_(pf), ei = 0.125f * __expf(pi);
#pragma unroll
            for (int e = 0; e < 8; ++e) { k[e] *= ei; la[e] = lf; }
        }
        if (MIX == 2) {
#pragma unroll
            for (int e = 0; e < 8; ++e) { k[e] *= 0.125f; la[e] = cA; }
            if (tid < 16 && j + 1 >= 4 && j + 1 < 132) {
                const int cn = d ? 127 - (j + 1 - 4) : (j + 1 - 4); float sn_, cs_; sincos_red((float)cn, exp2f(-(float)tid * (13.287712379549449f / 16.f)), sn_, cs_);
                ROWT[((j + 1) & 1) * 32 + tid] = cs_; ROWT[((j + 1) & 1) * 32 + 16 + tid] = sn_; }
            if (!is_ctx) {
                const int colpos = d ? 63 - gs : gs;
                float qp[8], kp[8]; unpack8(rd0, qp); unpack8(re0, kp);
#pragma unroll
                for (int e = 0; e < 8; ++e) {
                    float sn, cs;
                    if (w < 4) { cs = ROWT[(j & 1) * 32 + (w & 1) * 8 + e]; sn = ROWT[(j & 1) * 32 + 16 + (w & 1) * 8 + e]; } else { sn = COLS[((w & 1) * 8 + e) * 64 + colpos]; cs = COLC[((w & 1) * 8 + e) * 64 + colpos]; }
                    const float kpe = kp[e] * 0.125f;
                    if ((w & 2) == 0) { q[e] = q[e] * cs - qp[e] * sn; k[e] = k[e] * cs - kpe * sn; } else { q[e] = qp[e] * sn + q[e] * cs; k[e] = kpe * sn + k[e] * cs; }
                }
            }
        }
        if (MIX == 3) {
            float z0[8], z1[8]; unpack8(rd0, z0); unpack8(re0, z1);
            float za[4];
#pragma unroll
            for (int e = 0; e < 4; ++e) za[e] = BA[cq0 + e];
#pragma unroll
            for (int r = 0; r < 8; ++r) {
#pragma unroll
                for (int e = 0; e < 4; ++e) za[e] += z0[r] * WA[r * 32 + cq0 + e] + z1[r] * WA[(r + 8) * 32 + cq0 + e]; }
#pragma unroll
            for (int e = 0; e < 4; ++e) { la[e] = logsigmoidf_(za[e]) * (1.f / 16.f); k[e] *= 0.17677669529663687f; }
#pragma unroll
            for (int e = 4; e < 8; ++e) { la[e] = 0.f; q[e] = 0.f; k[e] = 0.f; }
        }
        wave_incl_scanN<NQ>(la);
        {
            float qm[8], qd[8], km[8], dlv[8];
#pragma unroll
            for (int e = 0; e < 8; ++e) { qm[e] = 0.f; qd[e] = 0.f; km[e] = 0.f; dlv[e] = 1.f; }
#pragma unroll
            for (int e = 0; e < NQ; ++e) { const float bb = la[e], bm = rdlane(bb, 31), bl = rdlane(bb, 63);
                const float E1 = __expf(fminf(fmaxf(bb - bm, -80.f), 80.f)), R1 = __builtin_amdgcn_rcpf(E1), Em = __expf(bm), Elm = __expf(bl - bm);
                qm[e] = q[e] * E1; qd[e] = qm[e] * Em; km[e] = k[e] * R1;
                KET[(cq0 + e) * RS + gs] = bf1(km[e] * Elm);
                dlv[e] = Em * Elm; }
#pragma unroll
            for (int e = 0; e < 8; ++e) VT[(c0 + e) * RS + gs] = bf1(v[e]);
            if (MIX == 3) {
                if (lane == 63) *(LAS f32x4*)(DL + cq0) = (f32x4){dlv[0], dlv[1], dlv[2], dlv[3]};
                const u32x4 pq = pack8(qm), pd = pack8(qd), pk = pack8(km);
                *(LAS u32x2*)(QM + gs * RS + cq0) = (u32x2){pq.x, pq.y}; *(LAS u32x2*)(QD + gs * RS + cq0) = (u32x2){pd.x, pd.y}; *(LAS u32x2*)(KM + gs * RS + cq0) = (u32x2){pk.x, pk.y};
            } else {
                if (lane == 63) { *(LAS f32x4*)(DL + c0) = (f32x4){dlv[0], dlv[1], dlv[2], dlv[3]}; *(LAS f32x4*)(DL + c0 + 4) = (f32x4){dlv[4], dlv[5], dlv[6], dlv[7]}; }
                *(LAS u32x4*)(QM + gs * RS + c0) = pack8(qm); *(LAS u32x4*)(QD + gs * RS + c0) = pack8(qd); *(LAS u32x4*)(KM + gs * RS + c0) = pack8(km);
            }
        }
        }
        LBAR();
        if (i >= 0) {
        bf16x8 av[2], as_[2];
#pragma unroll
        for (int kk = 0; kk < 2; ++kk) { av[kk] = *(const LAS bf16x8*)(VT + (vt * 16 + fr) * RS + kk * 32 + fq * 8); as_[kk] = *(const LAS bf16x8*)(STc + (vt * 16 + fr) * RS + kk * 32 + fq * 8); }
        f32x4 o[2], U[2];
#pragma unroll
        for (int ti = 0; ti < 2; ++ti) { const int tt = tp + ti; f32x4 acc = {0.f, 0.f, 0.f, 0.f};
#pragma unroll
            for (int kk = 0; kk < 2; ++kk) { const bf16x8 b1 = *(const LAS bf16x8*)(AT + (tt * 16 + fr) * RS + kk * 32 + fq * 8); acc = __builtin_amdgcn_mfma_f32_16x16x32_bf16(av[kk], b1, acc, 0, 0, 0);
                const bf16x8 b2 = *(const LAS bf16x8*)(QD + (tt * 16 + fr) * RS + kk * 32 + fq * 8); acc = __builtin_amdgcn_mfma_f32_16x16x32_bf16(as_[kk], b2, acc, 0, 0, 0); }
            o[ti] = acc; }
#pragma unroll
        for (int ci2 = 0; ci2 < 2; ++ci2) { const int ct = tp + ci2; f32x4 acc = {0.f, 0.f, 0.f, 0.f};
#pragma unroll
            for (int kk = 0; kk < 2; ++kk) { const bf16x8 b1 = *(const LAS bf16x8*)(KET + (ct * 16 + fr) * RS + kk * 32 + fq * 8); acc = __builtin_amdgcn_mfma_f32_16x16x32_bf16(av[kk], b1, acc, 0, 0, 0); }
            U[ci2] = acc; }
        if (MIX == 1) {
            float a8[8], q8[8]; unpack8(*(const LAS u32x4*)(AT + ds * RS + dc0), a8); unpack8(*(const LAS u32x4*)(QD + ds * RS + dc0), q8);
            const f32x4 n0 = *(const LAS f32x4*)(NST + dc0), n1 = *(const LAS f32x4*)(NST + dc0 + 4);
            float dsum = (a8[0] + a8[1]) + (a8[2] + a8[3]) + (a8[4] + a8[5]) + (a8[6] + a8[7]);
            dsum += q8[0] * n0.x + q8[1] * n0.y + q8[2] * n0.z + q8[3] * n0.w + q8[4] * n1.x + q8[5] * n1.y + q8[6] * n1.z + q8[7] * n1.w;
            dsum += __shfl_xor(dsum, 1); dsum += __shfl_xor(dsum, 2); dsum += __shfl_xor(dsum, 4);
            if ((tid & 7) == 0) DEN[ds] = dsum;
            LBAR();
#pragma unroll
            for (int ti = 0; ti < 2; ++ti) { const float dd = DEN[(tp + ti) * 16 + fr]; o[ti] = o[ti] * (1.f / fmaxf(fabsf(dd), 1.f)); }
        }
        if (!(is_ctx && last)) {
#pragma unroll
            for (int ti = 0; ti < 2; ++ti) { const int t = (tp + ti) * 16 + fr; const int grow = base + (d ? 63 - t : t);
                u32x2 wv; wv.x = pk_bf16(o[ti][0], o[ti][1]); wv.y = pk_bf16(o[ti][2], o[ti][3]); *(u32x2*)(Y + (size_t)grow * DM + ycol + vt * 16 + fq * 4) = wv; }
        }
        { const float dl0 = DL[tp * 16 + fr], dl1 = DL[(tp + 1) * 16 + fr]; S0 = S0 * dl0 + U[0]; S1 = S1 * dl1 + U[1]; }
#pragma unroll
        for (int j = 0; j < 4; ++j) { STn[(vt * 16 + fq * 4 + j) * RS + tp * 16 + fr] = bf1(S0[j]); STn[(vt * 16 + fq * 4 + j) * RS + (tp + 1) * 16 + fr] = bf1(S1[j]); }
        if (MIX == 1) {
            float k8[8]; unpack8(*(const LAS u32x4*)(KET + ds * RS + dc0), k8);
            float ks = (k8[0] + k8[1]) + (k8[2] + k8[3]) + (k8[4] + k8[5]) + (k8[6] + k8[7]);
            ks += __shfl_xor(ks, 1); ks += __shfl_xor(ks, 2); ks += __shfl_xor(ks, 4);
            if ((tid & 7) == 0) NST[ds] = DL[ds] * NST[ds] + ks;
        }
        }
        LBAR();
    }
#undef SCAN_LOAD
    __syncthreads();
}
__device__ __forceinline__ void scan_phase(const Params& p, const int layer, const bool last, LAS unsigned char* lds) {
    for (int id = blockIdx.x; id < 256; id += gridDim.x) {
        const int d = id & 1, h = (id >> 1) & 3, mix = (id >> 3) & 3, b = id >> 5;
        __syncthreads();
        if (mix == 0) scan_chain<0>(p, layer, last, b, h, d, lds);
        else if (mix == 1) scan_chain<1>(p, layer, last, b, h, d, lds);
        else if (mix == 2) scan_chain<2>(p, layer, last, b, h, d, lds);
        else scan_chain<3>(p, layer, last, b, h, d, lds);
    }
}

#define XB_TMO      128
#define XB_XCNT(j)  (256  + 64 * (j))
#define XB_XSUB(j)  (1280 + 64 * (j))
#define XB_XGEN(j)  (2304 + 64 * (j))
#define XB_TOP      3328
#define XB_TOPGEN   3392
#define XCD_BAR_WORDS 3456
#define XB_SPIN_CAP (1u << 18)

__device__ __forceinline__ unsigned xb_ld(unsigned* p)              { return __hip_atomic_load(p, __ATOMIC_RELAXED, __HIP_MEMORY_SCOPE_AGENT); }
__device__ __forceinline__ unsigned xb_add(unsigned* p, unsigned v) { return __hip_atomic_fetch_add(p, v, __ATOMIC_RELAXED, __HIP_MEMORY_SCOPE_AGENT); }
__device__ __forceinline__ unsigned xb_xcc_id() { return (unsigned)__builtin_amdgcn_s_getreg((3 << 11) | 20) & 0xFu; }
#define XB_SPIN(cond, bar) do { unsigned _sp = 0; while (cond) { __builtin_amdgcn_s_sleep(1); \
    if ((++_sp & 255u) == 0u) { if (xb_ld(&(bar)[XB_TMO])) break; if (_sp > XB_SPIN_CAP) { atomicAdd(&(bar)[XB_TMO], 1u); break; } } } } while (0)

struct XcdBarrier {
    unsigned* bar; unsigned x;
    volatile LAS unsigned* st;
};

__device__ __forceinline__ XcdBarrier xcd_barrier_post(unsigned* bar, volatile LAS unsigned* st) {
    XcdBarrier b; b.bar = bar; b.x = xb_xcc_id(); b.st = st;
    if (threadIdx.x == 0) (void)xb_add(&bar[XB_XCNT(b.x)], 1u);
    return b;
}
__device__ __forceinline__ void xcd_barrier_complete(unsigned* bar, unsigned x, unsigned& nloc, unsigned& nx) {
    const unsigned G = gridDim.x * gridDim.y * gridDim.z;
    unsigned sum, cnt, mine, sp = 0u;
    for (;;) {
        sum = 0u; cnt = 0u; mine = 0u;
#pragma unroll
        for (unsigned j = 0; j < 16; ++j) { const unsigned c = xb_ld(&bar[XB_XCNT(j)]); sum += c; cnt += (c > 0u) ? 1u : 0u; mine = (j == x) ? c : mine; }
        if (sum == G) break;
        __builtin_amdgcn_s_sleep(1);
        if ((++sp & 255u) == 0u) { if (xb_ld(&bar[XB_TMO])) break; if (sp > XB_SPIN_CAP) { atomicAdd(&bar[XB_TMO], 1u); break; } }
    }
    nloc = mine > 0u ? mine : 1u; nx = cnt > 0u ? cnt : 1u;
}

__device__ __forceinline__ void xcd_barrier(const XcdBarrier& b) {
    asm volatile("s_waitcnt vmcnt(0)" ::: "memory");
    __syncthreads();
    if (threadIdx.x == 0) {
        unsigned* bar = b.bar;
        __builtin_amdgcn_s_waitcnt(0);
        unsigned nloc = b.st[0], nx = b.st[1];
        if (nloc == 0u) { xcd_barrier_complete(bar, b.x, nloc, nx); b.st[0] = nloc; b.st[1] = nx; }
        const unsigned old = xb_add(&bar[XB_XSUB(b.x)], 1u);
        const unsigned gen = old / nloc;
        if (old + 1u == (gen + 1u) * nloc) {
            __builtin_amdgcn_fence(__ATOMIC_RELEASE, "agent");
            asm volatile("s_waitcnt vmcnt(0)" ::: "memory");
            const unsigned og = xb_add(&bar[XB_TOP], 1u);
            const unsigned tg = og / nx;
            if (og + 1u == (tg + 1u) * nx) xb_add(&bar[XB_TOPGEN], 1u);
            else XB_SPIN(xb_ld(&bar[XB_TOPGEN]) == tg, bar);
            __builtin_amdgcn_fence(__ATOMIC_ACQUIRE, "agent");
            xb_add(&bar[XB_XGEN(b.x)], 1u);
            asm volatile("s_waitcnt vmcnt(0)" ::: "memory");
        } else {
            XB_SPIN(xb_ld(&bar[XB_XGEN(b.x)]) == gen, bar);
            __builtin_amdgcn_fence(__ATOMIC_ACQUIRE, "agent");
            asm volatile("s_waitcnt vmcnt(0)" ::: "memory");
        }
    }
    __syncthreads();
}

__global__ void __launch_bounds__(512, 2) mega(Params p) {
    extern __shared__ __attribute__((aligned(16))) unsigned char lds_raw[];
    LAS unsigned char* lds = (LAS unsigned char*)lds_raw;
    cgrp::grid_group grid = cgrp::this_grid();
    const int lo = p.ph_lo, hi = p.ph_hi;
#define IN(k) (lo <= (k) && (k) < hi)
    constexpr int L_XB = LDS_BYTES - 128;
    if (threadIdx.x < 2) ((LAS unsigned*)(lds + L_XB))[threadIdx.x] = 0u;
    __syncthreads();
    XcdBarrier xbar = xcd_barrier_post((unsigned*)p.ws, (volatile LAS unsigned*)(lds + L_XB));
#define SYNC(k) do { if (lo <= (k) && (k) + 1 < hi) { if ((k) == 0) grid.sync(); else xcd_barrier(xbar); } } while (0)
    unsigned char* ws = p.ws;
    float* mod = (float*)(ws + WS_MOD); float* xc = (float*)(ws + WS_XC);
    bf16* H = (bf16*)(ws + WS_H); bf16* YF = (bf16*)(ws + WS_YF); bf16* PB = (bf16*)(ws + WS_P);

    float* ss1 = (float*)(ws + WS_SS1); float* ss2 = (float*)(ws + WS_SS2); const float* biasb = (const float*)(ws + WS_BIAS);
    if (IN(0)) { prologue_phase(p, lds); } SYNC(0);
    if (IN(1)) { init_scale_phase(p.x, p.ctx, mod, DM, H, ss2); bias_gemv_phase(p, lds, 0, 0); } SYNC(1);
    for (int l = 0; l < 2; ++l) {
        const int pb = 2 + 6 * l; const bool last = l == 1; const int Mrows = last ? MLAT : MALL;
        const float* modl = mod + (size_t)l * 9 * MODW;
        if (IN(pb + 0)) { pg8::Gemm g{H, (const bf16*)(ws + WS_WIN + l * WIN_BYTES), MALL, INP, DM}; pg8::StaticOrder S; S.init(MALL, INP, (int)gridDim.x, (int)blockIdx.x);
            EpiNormAct<0, INP> E{PB, ss2, biasb + (size_t)(l * 2 + 0) * 9 * INP};
            pg8::gemm_phase<EpiNormAct<0, INP>, pg8::StaticOrder, true, true>(lds, g, S, E); }
        SYNC(pb + 0);
        if (IN(pb + 1)) { scan_phase(p, l, last, lds); }
        SYNC(pb + 1);
        if (IN(pb + 2)) { gate_phase(p, l, Mrows); }
        SYNC(pb + 2);
        if (IN(pb + 3)) { pg8::Gemm g{YF, (const bf16*)(ws + WS_WOUT + l * 2 * MiB), Mrows, DM, DM}; pg8::StaticOrder S; S.init(Mrows, DM, (int)gridDim.x, (int)blockIdx.x);
            EpiResNorm E{l == 0 ? p.x : p.out, l == 0 ? p.ctx : xc, p.out, xc, modl + 2 * DM, modl + 4 * DM, H, ss1, 1};
            pg8::gemm_phase<EpiResNorm, pg8::StaticOrder, true, true>(lds, g, S, E); }
        SYNC(pb + 3);
        if (IN(pb + 4)) { pg8::Gemm g{H, (const bf16*)(ws + WS_WFF1 + l * 8 * MiB), Mrows, DFF, DM}; pg8::StaticOrder S; S.init(Mrows, DFF, (int)gridDim.x, (int)blockIdx.x);
            EpiNormAct<1, DFF> E{PB, ss1, biasb + (size_t)(l * 2 + 1) * 9 * INP};
            pg8::gemm_phase<EpiNormAct<1, DFF>, pg8::StaticOrder, true, true>(lds, g, S, E); }
        SYNC(pb + 4);
        if (IN(pb + 5)) { pg8::Gemm g{PB, (const bf16*)(ws + WS_WFF2 + l * 8 * MiB), Mrows, DM, DFF}; pg8::StaticOrder S; S.init(Mrows, DM, (int)gridDim.x, (int)blockIdx.x);
            EpiResNorm E{p.out, xc, p.out, xc, modl + 5 * DM, last ? (const float*)nullptr : mod + (size_t)9 * MODW + DM, H, ss2, last ? 0 : 1};
            pg8::gemm_phase<EpiResNorm, pg8::StaticOrder, true, true>(lds, g, S, E);
            if (!last) { prep_layer1_weights(p, lds, 32); bias_gemv_phase(p, lds, 1, 32); } }
        SYNC(pb + 5);
    }
    if (IN(14)) { final_norm_phase(p.out, H, p.g_final, ss2); }
#undef IN
#undef SYNC
}

extern "C" void kernel_launch(void* const* d_in, const int* in_sizes, int n_in, void* d_out, int out_size, void* d_ws, size_t ws_size, hipStream_t stream) {
    static int grid = 0;
    if (grid == 0) {
        int dev = 0, cus = 0, per_cu = 0;
        (void)hipGetDevice(&dev); (void)hipDeviceGetAttribute(&cus, hipDeviceAttributeMultiprocessorCount, dev);
        if (hipFuncSetAttribute((const void*)mega, hipFuncAttributeMaxDynamicSharedMemorySize, LDS_BYTES) != hipSuccess) fprintf(stderr, "kernel_launch: hipFuncSetAttribute failed\n");
        if (hipOccupancyMaxActiveBlocksPerMultiprocessor(&per_cu, (const void*)mega, 512, LDS_BYTES) != hipSuccess || per_cu < 1) { fprintf(stderr, "kernel_launch: occupancy query says %d\n", per_cu); per_cu = 1; }
        (void)hipGetLastError();
        grid = cus * per_cu; if (grid <= 0) grid = 256;
    }
    Params p{};
    p.x = (const float*)d_in[0]; p.c = (const float*)d_in[1]; p.ctx = (const float*)d_in[2]; p.c_ctx = (const float*)d_in[3]; p.w_ada = (const float*)d_in[4]; p.b_ada = (const float*)d_in[5];
    p.w_in = (const float*)d_in[6]; p.g_heads = (const float*)d_in[7]; p.lb_logits = (const float*)d_in[8]; p.ml_bias = (const float*)d_in[9]; p.rt_logit = (const float*)d_in[10];
    p.gla_w = (const float*)d_in[11]; p.gla_b = (const float*)d_in[12]; p.w_out = (const float*)d_in[13]; p.w_ff1 = (const float*)d_in[14]; p.w_ff2 = (const float*)d_in[15]; p.g_final = (const float*)d_in[16];
    p.out = (float*)d_out; p.ws = (unsigned char*)d_ws;
#if MK_MULTI
    for (int k = 0; k < NPHASE; ++k) { p.ph_lo = k; p.ph_hi = k + 1; hipLaunchKernelGGL(mega, dim3(grid), dim3(512), LDS_BYTES, stream, p); }
#else
    p.ph_lo = 0; p.ph_hi = NPHASE;
    if (hipMemsetAsync(d_ws, 0, 16384, stream) != hipSuccess) fprintf(stderr, "kernel_launch: memset of the barrier words failed\n");
    void* args[] = {&p};
    hipError_t e = hipLaunchCooperativeKernel((const void*)mega, dim3(grid), dim3(512), args, LDS_BYTES, stream);
    if (e != hipSuccess) fprintf(stderr, "cooperative launch failed: %s (grid %d)\n", hipGetErrorString(e), grid);
#endif
}
```
